# Optimizing an MI355X kernel written in HIP

```python
import math
import jax, jax.numpy as jnp
from jax import lax
import numpy as np

D_MODEL = 1024
BATCH = 8
SEQ = 2048
DEPTH = 2

CHUNK = 64
Q_BLOCK = 128
A_WIDTH = D_MODEL // 2
CONV_WIDTH = 31
B_WIDTH = D_MODEL // 2
LRU_BLOCKS = 8
LRU_BLOCK_DIM = B_WIDTH // LRU_BLOCKS
LRU_CONV_WIDTH = 4
LRU_C = 8.0
IN_WIDTH = 2 * A_WIDTH + 2 * B_WIDTH
DIFF_HEADS = D_MODEL // 128
DIFF_HEAD_DIM = 64
DIFF_V_DIM = 2 * DIFF_HEAD_DIM
QK_WIDTH = DIFF_HEADS * 2 * DIFF_HEAD_DIM
V_WIDTH = DIFF_HEADS * DIFF_V_DIM
ROPE_THETA = 10000.0
D_FF = ((8 * D_MODEL // 3 + 255) // 256) * 256
LN_EPS = 1e-5
DN_ALPHA = (2 * DEPTH) ** 0.25
DN_BETA = (8 * DEPTH) ** -0.25
N_EVEN = (DEPTH + 1) // 2
N_ODD = DEPTH // 2
NEG_INF = -1e30

kernel_name = 'hybrid_conv_lru_diffattn_streaming_encoder'


def layer_norm(x, g, b):
    xf = x.astype(jnp.float32)
    mu = jnp.mean(xf, axis=-1, keepdims=True)
    var = jnp.mean(jnp.square(xf - mu), axis=-1, keepdims=True)
    return ((xf - mu) * lax.rsqrt(var + LN_EPS)).astype(x.dtype) * g + b


def rms_norm(x, g):
    xf = x.astype(jnp.float32)
    return (xf * lax.rsqrt(jnp.mean(jnp.square(xf), axis=-1, keepdims=True) + LN_EPS)).astype(x.dtype) * g


def causal_depthwise_conv(x, w, b):
    k, c = w.shape
    y = lax.conv_general_dilated(x, w[:, None, :].astype(x.dtype), window_strides=(1,),
                                 padding=[(k - 1, 0)], dimension_numbers=('NWC', 'WIO', 'NWC'),
                                 feature_group_count=c)
    return y + b


def _linear_recurrence_combine(c1, c2):
    a1, u1 = c1
    a2, u2 = c2
    return a1 * a2, a2 * u1 + u2


def rg_lru(x, w_a, b_a, w_x, b_x, lam):
    bsz, seq, width = x.shape
    xb = x.reshape(bsz, seq, LRU_BLOCKS, LRU_BLOCK_DIM)
    gate_r = jax.nn.sigmoid((jnp.einsum('bsgi,gij->bsgj', xb, w_a).reshape(bsz, seq, width) + b_a).astype(jnp.float32))
    gate_i = jax.nn.sigmoid((jnp.einsum('bsgi,gij->bsgj', xb, w_x).reshape(bsz, seq, width) + b_x).astype(jnp.float32))
    log_a = -LRU_C * gate_r * jax.nn.softplus(-lam.astype(jnp.float32))
    a = jnp.exp(log_a)
    u = jnp.sqrt(-jnp.expm1(2.0 * log_a)) * (gate_i * x.astype(jnp.float32))
    _, h = lax.associative_scan(_linear_recurrence_combine, (a, u), axis=1)
    return h.astype(x.dtype)


def conv_lru_mixer(x, w_in, b_in, conv_w, conv_b, cnorm_g, cnorm_b, lru_conv_w, lru_conv_b,
                   w_a, b_a, w_x, b_x, lru_lambda, w_out):
    h = x @ w_in + b_in
    a_val = h[..., :A_WIDTH]
    a_gate = h[..., A_WIDTH:2 * A_WIDTH]
    b_gate = h[..., 2 * A_WIDTH:2 * A_WIDTH + B_WIDTH]
    b_rec = h[..., 2 * A_WIDTH + B_WIDTH:]
    ya = jax.nn.silu(layer_norm(causal_depthwise_conv(a_val * jax.nn.sigmoid(a_gate), conv_w, conv_b),
                                cnorm_g, cnorm_b))
    yb = rg_lru(causal_depthwise_conv(b_rec, lru_conv_w, lru_conv_b), w_a, b_a, w_x, b_x, lru_lambda) \
        * jax.nn.gelu(b_gate)
    return jnp.concatenate([ya, yb], axis=-1) @ w_out


def rotate_half(t):
    half = t.shape[-1] // 2
    return jnp.concatenate([-t[..., half:], t[..., :half]], axis=-1)


def diff_attention_mixer(x, w_qkv, lq1, lk1, lq2, lk2, subln_g, w_out, lambda_init):
    bsz, seq, _ = x.shape
    qkv = x @ w_qkv
    q = qkv[..., :QK_WIDTH].reshape(bsz, seq, DIFF_HEADS, 2, DIFF_HEAD_DIM)
    k = qkv[..., QK_WIDTH:2 * QK_WIDTH].reshape(bsz, seq, DIFF_HEADS, 2, DIFF_HEAD_DIM)
    v = qkv[..., 2 * QK_WIDTH:].reshape(bsz, seq, DIFF_HEADS, DIFF_V_DIM)
    pos = jnp.arange(seq, dtype=jnp.float32)
    inv_freq = ROPE_THETA ** (-jnp.arange(0, DIFF_HEAD_DIM, 2, dtype=jnp.float32) / DIFF_HEAD_DIM)
    ang = pos[:, None] * inv_freq[None, :]
    ang = jnp.concatenate([ang, ang], axis=-1)
    cos = jnp.cos(ang).astype(x.dtype)[:, None, None, :]
    sin = jnp.sin(ang).astype(x.dtype)[:, None, None, :]
    q = (q * cos + rotate_half(q) * sin) * (DIFF_HEAD_DIM ** -0.5)
    k = k * cos + rotate_half(k) * sin
    q = q.transpose(0, 2, 3, 1, 4)
    k = k.transpose(0, 2, 3, 1, 4)
    v = v.transpose(0, 2, 1, 3)
    lam = (jnp.exp(jnp.sum(lq1.astype(jnp.float32) * lk1.astype(jnp.float32)))
           - jnp.exp(jnp.sum(lq2.astype(jnp.float32) * lk2.astype(jnp.float32))) + lambda_init)
    chunk_id = jnp.arange(seq) // CHUNK
    outs = []
    for qb in range(seq // Q_BLOCK):
        s0, s1 = qb * Q_BLOCK, (qb + 1) * Q_BLOCK
        scores = jnp.einsum('bhmqd,bhmkd->bhmqk', q[:, :, :, s0:s1], k[:, :, :, :s1],
                            preferred_element_type=jnp.float32)
        mask = chunk_id[s0:s1, None] >= chunk_id[None, :s1]
        p = jax.nn.softmax(jnp.where(mask, scores, NEG_INF), axis=-1)
        attn = p[:, :, 0] - lam * p[:, :, 1]
        outs.append(jnp.einsum('bhqk,bhkd->bhqd', attn.astype(v.dtype), v[:, :, :s1]))
    o = jnp.concatenate(outs, axis=2)
    o = rms_norm(o, subln_g) * (1.0 - lambda_init)
    o = o.transpose(0, 2, 1, 3).reshape(bsz, seq, V_WIDTH)
    return o @ w_out


def swiglu(x, w_gate, w_up, w_down):
    return (jax.nn.silu(x @ w_gate) * (x @ w_up)) @ w_down


def setup_inputs(seed: int = 0) -> dict:
    key = jax.random.key(seed)
    ks = iter(jax.random.split(key, 40))
    f32 = jnp.float32

    def nrm(shape, scale):
        return scale * jax.random.normal(next(ks), shape, f32)

    def gain(shape):
        return 1.0 + nrm(shape, 0.02)

    a_pow = jax.random.uniform(next(ks), (N_EVEN, B_WIDTH), f32, minval=0.9, maxval=0.999)
    a0 = a_pow ** (1.0 / LRU_C)
    lru_lambda = jnp.log(a0) - jnp.log1p(-a0)
    return {
        'x': nrm((BATCH, SEQ, D_MODEL), 1.0),
        'even_w_in': nrm((N_EVEN, D_MODEL, IN_WIDTH), D_MODEL ** -0.5),
        'even_b_in': nrm((N_EVEN, IN_WIDTH), 0.01),
        'even_conv_w': nrm((N_EVEN, CONV_WIDTH, A_WIDTH), CONV_WIDTH ** -0.5),
        'even_conv_b': nrm((N_EVEN, A_WIDTH), 0.01),
        'even_cnorm_g': gain((N_EVEN, A_WIDTH)),
        'even_cnorm_b': nrm((N_EVEN, A_WIDTH), 0.01),
        'even_lru_conv_w': nrm((N_EVEN, LRU_CONV_WIDTH, B_WIDTH), LRU_CONV_WIDTH ** -0.5),
        'even_lru_conv_b': nrm((N_EVEN, B_WIDTH), 0.01),
        'even_w_a': nrm((N_EVEN, LRU_BLOCKS, LRU_BLOCK_DIM, LRU_BLOCK_DIM), LRU_BLOCK_DIM ** -0.5),
        'even_b_a': nrm((N_EVEN, B_WIDTH), 0.01),
        'even_w_x': nrm((N_EVEN, LRU_BLOCKS, LRU_BLOCK_DIM, LRU_BLOCK_DIM), LRU_BLOCK_DIM ** -0.5),
        'even_b_x': nrm((N_EVEN, B_WIDTH), 0.01),
        'even_lru_lambda': lru_lambda,
        'even_w_out': nrm((N_EVEN, A_WIDTH + B_WIDTH, D_MODEL), DN_BETA * (A_WIDTH + B_WIDTH) ** -0.5),
        'odd_w_qkv': nrm((N_ODD, D_MODEL, 2 * QK_WIDTH + V_WIDTH), D_MODEL ** -0.5),
        'odd_lambda_q1': nrm((N_ODD, DIFF_HEAD_DIM), 0.1),
        'odd_lambda_k1': nrm((N_ODD, DIFF_HEAD_DIM), 0.1),
        'odd_lambda_q2': nrm((N_ODD, DIFF_HEAD_DIM), 0.1),
        'odd_lambda_k2': nrm((N_ODD, DIFF_HEAD_DIM), 0.1),
        'odd_subln_g': gain((N_ODD, DIFF_V_DIM)),
        'odd_w_out': nrm((N_ODD, V_WIDTH, D_MODEL), DN_BETA * V_WIDTH ** -0.5),
        'mix_ln_g': gain((DEPTH, D_MODEL)),
        'mix_ln_b': nrm((DEPTH, D_MODEL), 0.01),
        'ffn_w_gate': nrm((DEPTH, D_MODEL, D_FF), D_MODEL ** -0.5),
        'ffn_w_up': nrm((DEPTH, D_MODEL, D_FF), D_MODEL ** -0.5),
        'ffn_w_down': nrm((DEPTH, D_FF, D_MODEL), DN_BETA * D_FF ** -0.5),
        'ffn_ln_g': gain((DEPTH, D_MODEL)),
        'ffn_ln_b': nrm((DEPTH, D_MODEL), 0.01),
    }


def reference(x, even_w_in, even_b_in, even_conv_w, even_conv_b, even_cnorm_g, even_cnorm_b,
              even_lru_conv_w, even_lru_conv_b, even_w_a, even_b_a, even_w_x, even_b_x,
              even_lru_lambda, even_w_out, odd_w_qkv, odd_lambda_q1, odd_lambda_k1,
              odd_lambda_q2, odd_lambda_k2, odd_subln_g, odd_w_out, mix_ln_g, mix_ln_b,
              ffn_w_gate, ffn_w_up, ffn_w_down, ffn_ln_g, ffn_ln_b):
    for layer in range(DEPTH):
        if layer % 2 == 0:
            e = layer // 2
            y = conv_lru_mixer(x, even_w_in[e], even_b_in[e], even_conv_w[e], even_conv_b[e],
                               even_cnorm_g[e], even_cnorm_b[e], even_lru_conv_w[e], even_lru_conv_b[e],
                               even_w_a[e], even_b_a[e], even_w_x[e], even_b_x[e],
                               even_lru_lambda[e], even_w_out[e])
        else:
            o = layer // 2
            lambda_init = 0.8 - 0.6 * math.exp(-0.3 * layer)
            y = diff_attention_mixer(x, odd_w_qkv[o], odd_lambda_q1[o], odd_lambda_k1[o],
                                     odd_lambda_q2[o], odd_lambda_k2[o], odd_subln_g[o],
                                     odd_w_out[o], lambda_init)
        x = layer_norm(DN_ALPHA * x + y, mix_ln_g[layer], mix_ln_b[layer])
        x = layer_norm(DN_ALPHA * x + swiglu(x, ffn_w_gate[layer], ffn_w_up[layer], ffn_w_down[layer]),
                       ffn_ln_g[layer], ffn_ln_b[layer])
    return x
```

```cpp
#include <hip/hip_runtime.h>
#include <hip/hip_cooperative_groups.h>
#include <cstdio>
#include <cstdint>
namespace cg = cooperative_groups;

#ifndef MK_SINGLE
#define MK_SINGLE 0
#endif

typedef unsigned short bf16_t;
typedef short bf16x8 __attribute__((ext_vector_type(8)));
typedef float f32x16 __attribute__((ext_vector_type(16)));
typedef __bf16 bf16x2_t __attribute__((ext_vector_type(2)));
typedef float f32x2_t __attribute__((ext_vector_type(2)));
typedef unsigned u32x4 __attribute__((ext_vector_type(4)));
#define DI __device__ __forceinline__
#define MFMA(a, b, c) __builtin_amdgcn_mfma_f32_32x32x16_bf16((a), (b), (c), 0, 0, 0)

constexpr int MT = 16384;
constexpr int DM = 1024;
constexpr int SEQ = 2048;
constexpr int DFF = 2816;
constexpr int NTHR = 512;
constexpr float LN_EPS = 1e-5f;
constexpr float DN_ALPHA = 1.4142135623730951f;
constexpr float LAMBDA_INIT = 0.35550906759096926f;

constexpr size_t MB = 1024 * 1024;
constexpr size_t OFF_W_IN = 0;
constexpr size_t OFF_W_OUT0 = OFF_W_IN + 4 * MB;
constexpr size_t OFF_W_GU0 = OFF_W_OUT0 + 2 * MB;
constexpr size_t OFF_W_DN0 = OFF_W_GU0 + (size_t)5632 * 1024 * 2;
constexpr size_t OFF_W_QKV = OFF_W_DN0 + (size_t)2816 * 1024 * 2;
constexpr size_t OFF_W_OUT1 = OFF_W_QKV + 6 * MB;
constexpr size_t OFF_W_GU1 = OFF_W_OUT1 + 2 * MB;
constexpr size_t OFF_W_DN1 = OFF_W_GU1 + (size_t)5632 * 1024 * 2;
constexpr size_t OFF_XB = OFF_W_DN1 + (size_t)2816 * 1024 * 2;
constexpr size_t OFF_MIX = OFF_XB + 32 * MB;
constexpr size_t OFF_REGA = OFF_MIX + 32 * MB;
constexpr size_t OFF_GLU = OFF_REGA;
constexpr size_t OFF_GB = OFF_REGA + 16 * MB;
constexpr size_t OFF_RB = OFF_REGA + 32 * MB;
constexpr size_t OFF_HLOC = OFF_REGA + 48 * MB;
constexpr size_t OFF_HID = OFF_REGA;
constexpr size_t OFF_Q = OFF_REGA;
constexpr size_t OFF_K = OFF_REGA + 32 * MB;
constexpr size_t OFF_VT = OFF_REGA + 64 * MB;
constexpr size_t OFF_PBUF = OFF_REGA + 96 * MB;
constexpr size_t OFF_AGG = OFF_PBUF + 32 * MB;
constexpr size_t OFF_ROPE = OFF_AGG + 2 * MB;

struct Params {
  const float* x; const float* w_in; const float* b_in; const float* conv_w; const float* conv_b;
  const float* cn_g; const float* cn_b; const float* lconv_w; const float* lconv_b;
  const float* w_a; const float* b_a; const float* w_x; const float* b_x; const float* lru_lam; const float* w_out0;
  const float* w_qkv; const float* lq1; const float* lk1; const float* lq2; const float* lk2; const float* subln_g; const float* w_out1;
  const float* mix_g; const float* mix_b; const float* ffn_gate; const float* ffn_up; const float* ffn_down;
  const float* ffn_g; const float* ffn_b;
  float* out; char* ws;
};

DI unsigned pk2(float lo, float hi) { f32x2_t v = {lo, hi}; bf16x2_t b = __builtin_convertvector(v, bf16x2_t); return __builtin_bit_cast(unsigned, b); }
DI bf16_t f2bf(float x) { return (bf16_t)(pk2(x, 0.f) & 0xffffu); }
DI float bf2f(bf16_t b) { return __uint_as_float(((unsigned)b) << 16); }
DI int crow(int i, int h) { return (i & 3) + 8 * (i >> 2) + 4 * h; }
DI float sigmoid_(float x) { return __builtin_amdgcn_rcpf(1.f + __expf(-x)); }
DI float silu_(float x) { return x * sigmoid_(x); }
DI float gelu_tanh(float x) {
  float y = 0.7978845608028654f * (x + 0.044715f * x * x * x);
  float t = 1.f - 2.f * __builtin_amdgcn_rcpf(1.f + __expf(2.f * y));
  return 0.5f * x * (1.f + t);
}
DI unsigned lds_off(int row, int chunk) { return (unsigned)(row * 64 + (((chunk ^ (row >> 2)) & 3) << 4)); }
DI float wave_sum(float v) {
#pragma unroll
  for (int o = 32; o >= 1; o >>= 1) v += __shfl_xor(v, o);
  return v;
}

DI void cvt_weight(bf16_t* __restrict__ dst, const float* __restrict__ s0, const float* __restrict__ s1,
                   int K, int Nsrc, int Np, int mode, int gtid, int gsz) {
  const int total = (K / 32) * Np;
  for (int idx = gtid; idx < total; idx += gsz) {
    const int kg = idx / Np, np = idx - kg * Np;
    const float* src = s0; int n = np;
    if (mode == 1) {
      const int blk = np >> 6, t = np & 63;
      if (blk < 16) n = (t < 32) ? (blk * 32 + t) : (512 + blk * 32 + (t - 32));
      else { const int j = blk - 16; n = (t < 32) ? (1024 + j * 32 + t) : (1536 + j * 32 + (t - 32)); }
    } else if (mode == 2) {
      const int blk = np >> 6, t = np & 63;
      src = (t < 32) ? s0 : s1; n = blk * 32 + (t & 31);
    }
    const float* p = src + (size_t)(kg * 32) * Nsrc + n;
    unsigned o[16];
#pragma unroll
    for (int kk = 0; kk < 16; ++kk) o[kk] = pk2(p[(size_t)(2 * kk) * Nsrc], p[(size_t)(2 * kk + 1) * Nsrc]);
    uint4* d = (uint4*)(dst + (size_t)idx * 32);
#pragma unroll
    for (int e = 0; e < 4; ++e) d[e] = make_uint4(o[4 * e], o[4 * e + 1], o[4 * e + 2], o[4 * e + 3]);
  }
}

DI void phase_prep(const Params& p) {
  const int gtid = blockIdx.x * NTHR + threadIdx.x, gsz = gridDim.x * NTHR;
  char* ws = p.ws;
  {
    bf16_t* xb = (bf16_t*)(ws + OFF_XB);
    for (int idx = gtid; idx < MT * 32; idx += gsz) {
      const int row = idx >> 5, kg = idx & 31;
      const float4* s = (const float4*)(p.x + (size_t)row * DM + kg * 32);
      uint4* d = (uint4*)(xb + ((size_t)kg * MT + row) * 32);
#pragma unroll
      for (int e = 0; e < 4; ++e) {
        float4 a = s[2 * e], b = s[2 * e + 1];
        d[e] = make_uint4(pk2(a.x, a.y), pk2(a.z, a.w), pk2(b.x, b.y), pk2(b.z, b.w));
      }
    }
  }
  cvt_weight((bf16_t*)(ws + OFF_W_IN), p.w_in, p.w_in, 1024, 2048, 2048, 1, gtid, gsz);
  cvt_weight((bf16_t*)(ws + OFF_W_OUT0), p.w_out0, p.w_out0, 1024, 1024, 1024, 0, gtid, gsz);
  cvt_weight((bf16_t*)(ws + OFF_W_GU0), p.ffn_gate, p.ffn_up, 1024, DFF, 2 * DFF, 2, gtid, gsz);
  cvt_weight((bf16_t*)(ws + OFF_W_DN0), p.ffn_down, p.ffn_down, DFF, 1024, 1024, 0, gtid, gsz);
  cvt_weight((bf16_t*)(ws + OFF_W_QKV), p.w_qkv, p.w_qkv, 1024, 3072, 3072, 0, gtid, gsz);
  cvt_weight((bf16_t*)(ws + OFF_W_OUT1), p.w_out1, p.w_out1, 1024, 1024, 1024, 0, gtid, gsz);
  cvt_weight((bf16_t*)(ws + OFF_W_GU1), p.ffn_gate + (size_t)1024 * DFF, p.ffn_up + (size_t)1024 * DFF, 1024, DFF, 2 * DFF, 2, gtid, gsz);
  cvt_weight((bf16_t*)(ws + OFF_W_DN1), p.ffn_down + (size_t)DFF * 1024, p.ffn_down + (size_t)DFF * 1024, DFF, 1024, 1024, 0, gtid, gsz);
  {
    float2* tab = (float2*)(ws + OFF_ROPE);
    for (int idx = gtid; idx < SEQ * 32; idx += gsz) {
      const int pos = idx >> 5, j = idx & 31;
      const float inv = powf(10000.0f, -(float)j / 32.0f);
      const float ang = (float)pos * inv;
      double t = (double)ang * 0.15915494309189535;
      t -= rint(t);
      const float tf = (float)t;
      tab[idx] = make_float2(__builtin_amdgcn_cosf(tf), __builtin_amdgcn_sinf(tf));
    }
  }
}

template <int BM, int BN, int WR, int WC, int G, class Epi>
DI void gemm_phase(const bf16_t* __restrict__ P1, int R1, const bf16_t* __restrict__ P2, int R2, int K, char* smem, const Epi& epi) {
  constexpr int MI = BM / WR / 32, NI = BN / WC / 32;
  static_assert(MI == 4 && NI == 2, "wave tile must be 128 x 64");
  constexpr int ROWS = BM + BN;
  constexpr int GRB = ROWS * 64;
  constexpr int STAGE = G * GRB;
  constexpr int CH1 = BM * 4, CH2 = BN * 4;
  constexpr int N1 = (G * CH1 + NTHR - 1) / NTHR, N2 = (G * CH2 + NTHR - 1) / NTHR;
  const int tid = threadIdx.x, lane = tid & 63, wave = tid >> 6;
  const int wr = wave / WC, wc = wave % WC;
  const int l32 = lane & 31, h = lane >> 5;
  const int tiles2 = R2 / BN, ntiles = (R1 / BM) * tiles2;
  const int KT = K / (32 * G);

  for (int tile = blockIdx.x; tile < ntiles; tile += gridDim.x) {
    const int t1 = tile / tiles2, t2 = tile - t1 * tiles2;
    const int o1 = t1 * BM, o2 = t2 * BN;
    u32x4 r1[N1], r2[N2];
    auto gload = [&](int kt) __attribute__((always_inline)) {
#pragma unroll
      for (int i = 0; i < N1; ++i) {
        const int q = tid + i * NTHR;
        if ((G * CH1) % NTHR == 0 || q < G * CH1) {
          const int g = q / CH1, r = q - g * CH1, row = r >> 2, c = r & 3;
          r1[i] = *(const u32x4*)(P1 + ((size_t)(kt * G + g) * R1 + o1 + row) * 32 + c * 8);
        }
      }
#pragma unroll
      for (int i = 0; i < N2; ++i) {
        const int q = tid + i * NTHR;
        if ((G * CH2) % NTHR == 0 || q < G * CH2) {
          const int g = q / CH2, r = q - g * CH2, row = r >> 2, c = r & 3;
          r2[i] = *(const u32x4*)(P2 + ((size_t)(kt * G + g) * R2 + o2 + row) * 32 + c * 8);
        }
      }
    };
    auto sstore = [&](int buf) __attribute__((always_inline)) {
      char* base = smem + buf * STAGE;
#pragma unroll
      for (int i = 0; i < N1; ++i) {
        const int q = tid + i * NTHR;
        if ((G * CH1) % NTHR == 0 || q < G * CH1) {
          const int g = q / CH1, r = q - g * CH1, row = r >> 2, c = r & 3;
          *(u32x4*)(base + g * GRB + lds_off(row, c)) = r1[i];
        }
      }
#pragma unroll
      for (int i = 0; i < N2; ++i) {
        const int q = tid + i * NTHR;
        if ((G * CH2) % NTHR == 0 || q < G * CH2) {
          const int g = q / CH2, r = q - g * CH2, row = BM + (r >> 2), c = r & 3;
          *(u32x4*)(base + g * GRB + lds_off(row, c)) = r2[i];
        }
      }
    };

    f32x16 acc[MI][NI];
#pragma unroll
    for (int mi = 0; mi < MI; ++mi)
#pragma unroll
      for (int ni = 0; ni < NI; ++ni)
#pragma unroll
        for (int i = 0; i < 16; ++i) acc[mi][ni][i] = 0.f;

    __syncthreads();
    gload(0);
    sstore(0);
    __syncthreads();
    for (int kt = 0; kt < KT; ++kt) {
      const bool more = (kt + 1 < KT);
      if (more) gload(kt + 1);
      const char* base = smem + (kt & 1) * STAGE;
#pragma unroll
      for (int ks = 0; ks < 2 * G; ++ks) {
        const char* gb = base + (ks >> 1) * GRB;
        const int chunk = (ks & 1) * 2 + h;
        bf16x8 a[MI], b[NI];
#pragma unroll
        for (int mi = 0; mi < MI; ++mi) a[mi] = *(const bf16x8*)(gb + lds_off(wr * (BM / WR) + mi * 32 + l32, chunk));
#pragma unroll
        for (int ni = 0; ni < NI; ++ni) b[ni] = *(const bf16x8*)(gb + lds_off(BM + wc * (BN / WC) + ni * 32 + l32, chunk));
#pragma unroll
        for (int mi = 0; mi < MI; ++mi)
#pragma unroll
          for (int ni = 0; ni < NI; ++ni) acc[mi][ni] = MFMA(a[mi], b[ni], acc[mi][ni]);
      }
      if (more) sstore((kt + 1) & 1);
      __syncthreads();
    }
    epi(acc, o1 + wr * (BM / WR), o2 + wc * (BN / WC), lane, smem);
  }
}

struct EpiInProj {
  const float* b_in; bf16_t* glu; bf16_t* gb; bf16_t* rb;
  DI void operator()(f32x16 (&acc)[4][2], int row0, int col0, int lane, char*) const {
    const int l32 = lane & 31, h = lane >> 5;
    const int blk = col0 >> 6;
    const bool isA = blk < 16;
    const int ch = (isA ? blk : blk - 16) * 32 + l32;
    const float b0 = b_in[(isA ? 0 : 1024) + ch], b1 = b_in[(isA ? 512 : 1536) + ch];
#pragma unroll
    for (int mi = 0; mi < 4; ++mi)
#pragma unroll
      for (int i = 0; i < 16; ++i) {
        const size_t row = row0 + mi * 32 + crow(i, h);
        const float v0 = acc[mi][0][i] + b0, v1 = acc[mi][1][i] + b1;
        if (isA) glu[row * 512 + ch] = f2bf(v0 * sigmoid_(v1));
        else { gb[row * 512 + ch] = f2bf(gelu_tanh(v0)); rb[row * 512 + ch] = f2bf(v1); }
      }
  }
};
struct EpiSwiGLU {
  bf16_t* hid;
  DI void operator()(f32x16 (&acc)[4][2], int row0, int col0, int lane, char*) const {
    const int l32 = lane & 31, h = lane >> 5;
    const size_t kg = col0 >> 6;
#pragma unroll
    for (int mi = 0; mi < 4; ++mi)
#pragma unroll
      for (int i = 0; i < 16; ++i) {
        const size_t row = row0 + mi * 32 + crow(i, h);
        hid[(kg * MT + row) * 32 + l32] = f2bf(silu_(acc[mi][0][i]) * acc[mi][1][i]);
      }
  }
};
struct EpiQKV {
  bf16_t* q; bf16_t* k; bf16_t* vt; const float2* rope; float qscale;
  DI void operator()(f32x16 (&acc)[4][2], int row0, int col0, int lane, char*) const {
    const int l32 = lane & 31, h = lane >> 5;
    const int sect = col0 >> 10, within = col0 & 1023, head = within >> 7;
    const int b = row0 >> 11;
    if (sect < 2) {
      const int m = (within >> 6) & 1;
      bf16_t* dst = (sect == 0) ? q : k;
      const float sc = (sect == 0) ? qscale : 1.f;
      const size_t base0 = ((size_t)((b * 8 + head) * 2 + m) * 2 + 0) * SEQ;
      const size_t base1 = ((size_t)((b * 8 + head) * 2 + m) * 2 + 1) * SEQ;
#pragma unroll
      for (int mi = 0; mi < 4; ++mi)
#pragma unroll
        for (int i = 0; i < 16; ++i) {
          const int pos = ((row0 + mi * 32) & (SEQ - 1)) + crow(i, h);
          const float2 cs = rope[pos * 32 + l32];
          const float lo = acc[mi][0][i], hi = acc[mi][1][i];
          const float olo = (lo * cs.x - hi * cs.y) * sc, ohi = (hi * cs.x + lo * cs.y) * sc;
          dst[(base0 + pos) * 32 + l32] = f2bf(olo);
          dst[(base1 + pos) * 32 + l32] = f2bf(ohi);
        }
    } else {
      const int vd0 = within & 127;
#pragma unroll
      for (int mi = 0; mi < 4; ++mi) {
        const int pos0 = (row0 + mi * 32) & (SEQ - 1);
        const size_t sg = pos0 >> 5;
#pragma unroll
        for (int ni = 0; ni < 2; ++ni) {
          const int vdim = vd0 + ni * 32 + l32;
          bf16_t* d = vt + (((size_t)(b * 8 + head) * 64 + sg) * 128 + vdim) * 32;
#pragma unroll
          for (int jq = 0; jq < 4; ++jq) {
            const int ppos = 16 * (jq >> 1) + 8 * h + 4 * (jq & 1);
            uint2 v = make_uint2(pk2(acc[mi][ni][4 * jq], acc[mi][ni][4 * jq + 1]), pk2(acc[mi][ni][4 * jq + 2], acc[mi][ni][4 * jq + 3]));
            *(uint2*)(d + ppos) = v;
          }
        }
      }
    }
  }
};
struct EpiLN {
  const float* res; float* outf; bf16_t* outb; const float* g; const float* bt;
  DI void operator()(f32x16 (&acc)[4][2], int f0, int t0, int lane, char* smem) const {
    const int l32 = lane & 31, h = lane >> 5, wave = threadIdx.x >> 6;
    float s[2], ss[2];
#pragma unroll
    for (int ni = 0; ni < 2; ++ni) {
      const size_t tok = t0 + ni * 32 + l32;
      float a = 0.f, a2 = 0.f;
#pragma unroll
      for (int mi = 0; mi < 4; ++mi)
#pragma unroll
        for (int jq = 0; jq < 4; ++jq) {
          const int f = f0 + mi * 32 + 8 * jq + 4 * h;
          const float4 r = *(const float4*)(res + tok * DM + f);
          float z0 = DN_ALPHA * r.x + acc[mi][ni][4 * jq + 0];
          float z1 = DN_ALPHA * r.y + acc[mi][ni][4 * jq + 1];
          float z2 = DN_ALPHA * r.z + acc[mi][ni][4 * jq + 2];
          float z3 = DN_ALPHA * r.w + acc[mi][ni][4 * jq + 3];
          acc[mi][ni][4 * jq + 0] = z0; acc[mi][ni][4 * jq + 1] = z1; acc[mi][ni][4 * jq + 2] = z2; acc[mi][ni][4 * jq + 3] = z3;
          a += (z0 + z1) + (z2 + z3);
          a2 += (z0 * z0 + z1 * z1) + (z2 * z2 + z3 * z3);
          if (jq == 3) __builtin_amdgcn_sched_barrier(0);
        }
      a += __shfl_xor(a, 32); a2 += __shfl_xor(a2, 32);
      s[ni] = a; ss[ni] = a2;
    }
    float* red = (float*)smem;
    if (h == 0) {
#pragma unroll
      for (int ni = 0; ni < 2; ++ni) { red[(wave * 64 + ni * 32 + l32) * 2] = s[ni]; red[(wave * 64 + ni * 32 + l32) * 2 + 1] = ss[ni]; }
    }
    __syncthreads();
#pragma unroll
    for (int ni = 0; ni < 2; ++ni) {
      float a = 0.f, a2 = 0.f;
#pragma unroll
      for (int w = 0; w < 8; ++w) { const float2 v = *(const float2*)(red + (w * 64 + ni * 32 + l32) * 2); a += v.x; a2 += v.y; }
      const float mean = a * (1.f / 1024.f);
      const float var = fmaxf(a2 * (1.f / 1024.f) - mean * mean, 0.f);
      const float rstd = rsqrtf(var + LN_EPS);
      const size_t tok = t0 + ni * 32 + l32;
#pragma unroll
      for (int mi = 0; mi < 4; ++mi)
#pragma unroll
        for (int jq = 0; jq < 4; ++jq) {
          const int f = f0 + mi * 32 + 8 * jq + 4 * h;
          const float4 gg = *(const float4*)(g + f), bb = *(const float4*)(bt + f);
          float4 o;
          o.x = (acc[mi][ni][4 * jq + 0] - mean) * rstd * gg.x + bb.x;
          o.y = (acc[mi][ni][4 * jq + 1] - mean) * rstd * gg.y + bb.y;
          o.z = (acc[mi][ni][4 * jq + 2] - mean) * rstd * gg.z + bb.z;
          o.w = (acc[mi][ni][4 * jq + 3] - mean) * rstd * gg.w + bb.w;
          *(float4*)(outf + tok * DM + f) = o;
          *(uint2*)(outb + ((size_t)(f >> 5) * MT + tok) * 32 + (f & 31)) = make_uint2(pk2(o.x, o.y), pk2(o.z, o.w));
          if (jq == 3) __builtin_amdgcn_sched_barrier(0);
        }
    }
  }
};

DI void phase_convlru(const Params& p, char* smem) {
  const int tid = threadIdx.x, lane = tid & 63, wave = tid >> 6;
  const int c = tid;
  char* ws = p.ws;
  const bf16_t* glu = (const bf16_t*)(ws + OFF_GLU);
  const bf16_t* rbuf = (const bf16_t*)(ws + OFF_RB);
  float* hloc = (float*)(ws + OFF_HLOC);
  float* pbuf = (float*)(ws + OFF_PBUF);
  float2* agg = (float2*)(ws + OFF_AGG);
  bf16_t* mix = (bf16_t*)(ws + OFF_MIX);
  bf16_t* sA = (bf16_t*)smem;
  float* sOut = (float*)(smem + 63488);
  bf16_t* sR = (bf16_t*)smem;
  float* sRf = (float*)(smem + 36864);

  for (int item = blockIdx.x; item < 512; item += gridDim.x) {
    const int b = item >> 6, ft = item & 63, t0 = ft * 32;
    const size_t rowbase = (size_t)b * SEQ;
    __syncthreads();
    for (int q = tid; q < 62 * 64; q += NTHR) {
      const int r = q >> 6, cc = q & 63, fr = t0 - 30 + r;
      uint4 v = make_uint4(0, 0, 0, 0);
      if (fr >= 0) v = *(const uint4*)(glu + (rowbase + fr) * 512 + cc * 8);
      *(uint4*)(sA + r * 512 + cc * 8) = v;
    }
    __syncthreads();
    {
      float cw[31];
#pragma unroll
      for (int j = 0; j < 31; ++j) cw[j] = p.conv_w[j * 512 + c];
      const float cb = p.conv_b[c];
      for (int t = 0; t < 32; ++t) {
        float a = cb;
#pragma unroll
        for (int j = 0; j < 31; ++j) a += cw[j] * bf2f(sA[(t + j) * 512 + c]);
        sOut[t * 512 + c] = a;
      }
    }
    __syncthreads();
    for (int t = wave; t < 32; t += 8) {
      float v[8]; float s = 0.f;
#pragma unroll
      for (int e = 0; e < 8; ++e) { v[e] = sOut[t * 512 + e * 64 + lane]; s += v[e]; }
      s = wave_sum(s);
      const float mean = s * (1.f / 512.f);
      float s2 = 0.f;
#pragma unroll
      for (int e = 0; e < 8; ++e) { const float d = v[e] - mean; s2 += d * d; }
      s2 = wave_sum(s2);
      const float rstd = rsqrtf(s2 * (1.f / 512.f) + LN_EPS);
      const size_t row = rowbase + t0 + t;
#pragma unroll
      for (int e = 0; e < 8; ++e) {
        const int ch = e * 64 + lane;
        const float y = (v[e] - mean) * rstd * p.cn_g[ch] + p.cn_b[ch];
        mix[((size_t)(ch >> 5) * MT + row) * 32 + (ch & 31)] = f2bf(silu_(y));
      }
    }
    __syncthreads();
    for (int q = tid; q < 35 * 64; q += NTHR) {
      const int r = q >> 6, cc = q & 63, fr = t0 - 3 + r;
      uint4 v = make_uint4(0, 0, 0, 0);
      if (fr >= 0) v = *(const uint4*)(rbuf + (rowbase + fr) * 512 + cc * 8);
      *(uint4*)(sR + r * 512 + cc * 8) = v;
    }
    __syncthreads();
    {
      const float w0 = p.lconv_w[c], w1 = p.lconv_w[512 + c], w2 = p.lconv_w[1024 + c], w3 = p.lconv_w[1536 + c];
      const float lb = p.lconv_b[c];
      for (int t = 0; t < 32; ++t) {
        float a = lb;
        a += w0 * bf2f(sR[(t + 0) * 512 + c]);
        a += w1 * bf2f(sR[(t + 1) * 512 + c]);
        a += w2 * bf2f(sR[(t + 2) * 512 + c]);
        a += w3 * bf2f(sR[(t + 3) * 512 + c]);
        sRf[t * 512 + c] = a;
      }
    }
    __syncthreads();
    {
      const int g = c >> 6, jj = c & 63;
      const float ba = p.b_a[c], bx = p.b_x[c];
      float pa[32], px[32];
#pragma unroll
      for (int t = 0; t < 32; ++t) { pa[t] = ba; px[t] = bx; }
#pragma unroll 1
      for (int i4 = 0; i4 < 16; ++i4) {
        const float* wap = p.w_a + (size_t)(g * 64 + 4 * i4) * 64 + jj;
        const float* wxp = p.w_x + (size_t)(g * 64 + 4 * i4) * 64 + jj;
        const float a0 = wap[0], a1 = wap[64], a2 = wap[128], a3 = wap[192];
        const float x0 = wxp[0], x1 = wxp[64], x2 = wxp[128], x3 = wxp[192];
#pragma unroll
        for (int t = 0; t < 32; ++t) {
          const float4 v = *(const float4*)(sRf + t * 512 + g * 64 + 4 * i4);
          pa[t] += v.x * a0; pa[t] += v.y * a1; pa[t] += v.z * a2; pa[t] += v.w * a3;
          px[t] += v.x * x0; px[t] += v.y * x1; px[t] += v.z * x2; px[t] += v.w * x3;
        }
      }
      const float sp = log1pf(__expf(-p.lru_lam[c]));
      float hcur = 0.f, pcur = 1.f;
#pragma unroll
      for (int t = 0; t < 32; ++t) {
        const float rme = sRf[t * 512 + c];
        const float gr = sigmoid_(pa[t]), gi = sigmoid_(px[t]);
        const float la = -8.0f * gr * sp;
        const float a = __expf(la);
        const float u = sqrtf(-expm1f(2.f * la)) * (gi * rme);
        hcur = a * hcur + u;
        pcur *= a;
        const size_t row = rowbase + t0 + t;
        hloc[row * 512 + c] = hcur;
        pbuf[row * 512 + c] = pcur;
      }
      agg[(size_t)(b * 64 + ft) * 512 + c] = make_float2(pcur, hcur);
    }
  }
}

DI void phase_lrufix(const Params& p) {
  const int c = threadIdx.x;
  char* ws = p.ws;
  const bf16_t* gb = (const bf16_t*)(ws + OFF_GB);
  const float* hloc = (const float*)(ws + OFF_HLOC);
  const float* pbuf = (const float*)(ws + OFF_PBUF);
  const float2* agg = (const float2*)(ws + OFF_AGG);
  bf16_t* mix = (bf16_t*)(ws + OFF_MIX);
  for (int item = blockIdx.x; item < 512; item += gridDim.x) {
    const int b = item >> 6, ft = item & 63;
    float carry = 0.f;
#pragma unroll 8
    for (int i = 0; i < ft; ++i) { const float2 a = agg[(size_t)(b * 64 + i) * 512 + c]; carry = a.x * carry + a.y; }
    const size_t row0 = (size_t)b * SEQ + ft * 32;
#pragma unroll 4
    for (int t = 0; t < 32; ++t) {
      const size_t row = row0 + t;
      const float hh = hloc[row * 512 + c] + pbuf[row * 512 + c] * carry;
      const float y = hh * bf2f(gb[row * 512 + c]);
      mix[((size_t)((512 + c) >> 5) * MT + row) * 32 + (c & 31)] = f2bf(y);
    }
  }
}

DI void phase_attn(const Params& p, char* smem) {
  const int tid = threadIdx.x, lane = tid & 63, wave = tid >> 6;
  const int l32 = lane & 31, h = lane >> 5;
  char* ws = p.ws;
  const bf16_t* qb = (const bf16_t*)(ws + OFF_Q);
  const bf16_t* kb_ = (const bf16_t*)(ws + OFF_K);
  const bf16_t* vt = (const bf16_t*)(ws + OFF_VT);
  bf16_t* mix = (bf16_t*)(ws + OFF_MIX);
  float d1 = 0.f, d2 = 0.f;
  for (int i = 0; i < 64; ++i) { d1 += p.lq1[i] * p.lk1[i]; d2 += p.lq2[i] * p.lk2[i]; }
  const float lam = expf(d1) - expf(d2) + LAMBDA_INIT;
  constexpr int STAGE = 512 * 64;

  for (int pr = blockIdx.x; pr < 256; pr += gridDim.x) {
    for (int half = 0; half < 2; ++half) {
      const int id = half ? (511 - pr) : pr;
      const int qblk = id >> 6, bh = id & 63;
      const int q0 = qblk * 256;
      const int T = q0 / 64 + 4;
      const int ntw = (q0 + wave * 32) / 64 + 1;
      const size_t kbase = (size_t)bh * 4 * SEQ * 32;
      const size_t vbase = (size_t)bh * 64 * 128 * 32;
      bf16x8 qf[2][4];
#pragma unroll
      for (int m = 0; m < 2; ++m)
#pragma unroll
        for (int ks = 0; ks < 4; ++ks)
          qf[m][ks] = *(const bf16x8*)(qb + kbase + ((size_t)(m * 2 + (ks >> 1)) * SEQ + q0 + wave * 32 + l32) * 32 + ((ks & 1) * 2 + h) * 8);

      u32x4 rk[2], rv[2];
      auto gloadK = [&](int t) __attribute__((always_inline)) {
#pragma unroll
        for (int i = 0; i < 2; ++i) {
          const int q = tid + i * NTHR, g4 = q >> 8, r = q & 255;
          rk[i] = *(const u32x4*)(kb_ + kbase + ((size_t)g4 * SEQ + t * 64) * 32 + r * 8);
        }
      };
      auto gloadV = [&](int t) __attribute__((always_inline)) {
#pragma unroll
        for (int i = 0; i < 2; ++i) {
          const int q = tid + i * NTHR;
          rv[i] = *(const u32x4*)(vt + vbase + (size_t)(t * 2) * 128 * 32 + (size_t)q * 8);
        }
      };
      auto sstoreK = [&](int buf) __attribute__((always_inline)) {
        char* base = smem + buf * STAGE;
#pragma unroll
        for (int i = 0; i < 2; ++i) {
          const int q = tid + i * NTHR, g4 = q >> 8, r = q & 255;
          *(u32x4*)(base + lds_off(g4 * 64 + (r >> 2), r & 3)) = rk[i];
        }
      };
      auto sstoreV = [&](int buf) __attribute__((always_inline)) {
        char* base = smem + buf * STAGE;
#pragma unroll
        for (int i = 0; i < 2; ++i) {
          const int q = tid + i * NTHR;
          *(u32x4*)(base + lds_off(256 + (q >> 2), q & 3)) = rv[i];
        }
      };

      float mx[2] = {-1e30f, -1e30f}, ls[2] = {0.f, 0.f};
      __syncthreads();
      gloadK(0); sstoreK(0);
      __syncthreads();
      for (int t = 0; t < T; ++t) {
        const bool more = (t + 1 < T);
        if (more) gloadK(t + 1);
        const char* base = smem + (t & 1) * STAGE;
        if (t < ntw) {
#pragma unroll
          for (int m = 0; m < 2; ++m)
#pragma unroll
            for (int kb = 0; kb < 2; ++kb) {
              f32x16 S;
#pragma unroll
              for (int i = 0; i < 16; ++i) S[i] = 0.f;
#pragma unroll
              for (int ks = 0; ks < 4; ++ks) {
                const bf16x8 a = *(const bf16x8*)(base + lds_off((m * 2 + (ks >> 1)) * 64 + kb * 32 + l32, (ks & 1) * 2 + h));
                S = MFMA(a, qf[m][ks], S);
              }
              float tm = S[0];
#pragma unroll
              for (int i = 1; i < 16; ++i) tm = fmaxf(tm, S[i]);
              const float mn = fmaxf(mx[m], tm);
              float acc = 0.f;
#pragma unroll
              for (int i = 0; i < 16; ++i) acc += __builtin_amdgcn_exp2f(S[i] - mn);
              ls[m] = ls[m] * __builtin_amdgcn_exp2f(mx[m] - mn) + acc;
              mx[m] = mn;
            }
        }
        if (more) sstoreK((t + 1) & 1);
        __syncthreads();
      }
      float invl[2];
#pragma unroll
      for (int m = 0; m < 2; ++m) {
        const float om = __shfl_xor(mx[m], 32), ol = __shfl_xor(ls[m], 32);
        const float mn = fmaxf(mx[m], om);
        const float l = ls[m] * __builtin_amdgcn_exp2f(mx[m] - mn) + ol * __builtin_amdgcn_exp2f(om - mn);
        mx[m] = mn; invl[m] = 1.f / l;
      }
      const float c2 = lam * invl[1];

      f32x16 O[4];
#pragma unroll
      for (int mi = 0; mi < 4; ++mi)
#pragma unroll
        for (int i = 0; i < 16; ++i) O[mi][i] = 0.f;
      gloadK(0); gloadV(0); sstoreK(0); sstoreV(0);
      __syncthreads();
      for (int t = 0; t < T; ++t) {
        const bool more = (t + 1 < T);
        if (more) { gloadK(t + 1); gloadV(t + 1); }
        const char* base = smem + (t & 1) * STAGE;
        if (t < ntw) {
#pragma unroll
          for (int kb = 0; kb < 2; ++kb) {
            f32x16 S1, S2;
#pragma unroll
            for (int i = 0; i < 16; ++i) { S1[i] = 0.f; S2[i] = 0.f; }
#pragma unroll
            for (int ks = 0; ks < 4; ++ks) {
              const bf16x8 a1 = *(const bf16x8*)(base + lds_off((0 + (ks >> 1)) * 64 + kb * 32 + l32, (ks & 1) * 2 + h));
              const bf16x8 a2 = *(const bf16x8*)(base + lds_off((2 + (ks >> 1)) * 64 + kb * 32 + l32, (ks & 1) * 2 + h));
              S1 = MFMA(a1, qf[0][ks], S1);
              S2 = MFMA(a2, qf[1][ks], S2);
            }
            float at[16];
#pragma unroll
            for (int i = 0; i < 16; ++i)
              at[i] = __builtin_amdgcn_exp2f(S1[i] - mx[0]) * invl[0] - __builtin_amdgcn_exp2f(S2[i] - mx[1]) * c2;
#pragma unroll
            for (int s = 0; s < 2; ++s) {
              u32x4 pw = {pk2(at[8 * s + 0], at[8 * s + 1]), pk2(at[8 * s + 2], at[8 * s + 3]),
                          pk2(at[8 * s + 4], at[8 * s + 5]), pk2(at[8 * s + 6], at[8 * s + 7])};
              const bf16x8 pf = __builtin_bit_cast(bf16x8, pw);
#pragma unroll
              for (int mi = 0; mi < 4; ++mi) {
                const bf16x8 va = *(const bf16x8*)(base + lds_off(256 + kb * 128 + mi * 32 + l32, 2 * s + h));
                O[mi] = MFMA(va, pf, O[mi]);
              }
            }
          }
        }
        if (more) { sstoreK((t + 1) & 1); sstoreV((t + 1) & 1); }
        __syncthreads();
      }
      float ssq = 0.f;
#pragma unroll
      for (int mi = 0; mi < 4; ++mi)
#pragma unroll
        for (int i = 0; i < 16; ++i) ssq += O[mi][i] * O[mi][i];
      ssq += __shfl_xor(ssq, 32);
      const float rs = rsqrtf(ssq * (1.f / 128.f) + LN_EPS) * (1.f - LAMBDA_INIT);
      const int bb = bh >> 3, head = bh & 7;
      const size_t tok = (size_t)bb * SEQ + q0 + wave * 32 + l32;
#pragma unroll
      for (int mi = 0; mi < 4; ++mi)
#pragma unroll
        for (int jq = 0; jq < 4; ++jq) {
          const int vd = mi * 32 + 8 * jq + 4 * h;
          const float4 gg = *(const float4*)(p.subln_g + vd);
          const unsigned w0 = pk2(O[mi][4 * jq + 0] * rs * gg.x, O[mi][4 * jq + 1] * rs * gg.y);
          const unsigned w1 = pk2(O[mi][4 * jq + 2] * rs * gg.z, O[mi][4 * jq + 3] * rs * gg.w);
          *(uint2*)(mix + ((size_t)(head * 4 + mi) * MT + tok) * 32 + (vd & 31)) = make_uint2(w0, w1);
        }
    }
  }
}

template <int PH>
DI void run_phase(const Params& p, char* smem) {
  char* ws = p.ws;
  const bf16_t* xb = (const bf16_t*)(ws + OFF_XB);
  const bf16_t* mixb = (const bf16_t*)(ws + OFF_MIX);
  if constexpr (PH == 0) phase_prep(p);
  if constexpr (PH == 1) {
    EpiInProj e{p.b_in, (bf16_t*)(ws + OFF_GLU), (bf16_t*)(ws + OFF_GB), (bf16_t*)(ws + OFF_RB)};
    gemm_phase<256, 256, 2, 4, 2>(xb, MT, (const bf16_t*)(ws + OFF_W_IN), 2048, 1024, smem, e);
  }
  if constexpr (PH == 2) phase_convlru(p, smem);
  if constexpr (PH == 3) phase_lrufix(p);
  if constexpr (PH == 4) {
    EpiLN e{p.x, p.out, (bf16_t*)(ws + OFF_XB), p.mix_g, p.mix_b};
    gemm_phase<1024, 64, 8, 1, 1>((const bf16_t*)(ws + OFF_W_OUT0), 1024, mixb, MT, 1024, smem, e);
  }
  if constexpr (PH == 5) {
    EpiSwiGLU e{(bf16_t*)(ws + OFF_HID)};
    gemm_phase<256, 256, 2, 4, 2>(xb, MT, (const bf16_t*)(ws + OFF_W_GU0), 2 * DFF, 1024, smem, e);
  }
  if constexpr (PH == 6) {
    EpiLN e{p.out, p.out, (bf16_t*)(ws + OFF_XB), p.ffn_g, p.ffn_b};
    gemm_phase<1024, 64, 8, 1, 1>((const bf16_t*)(ws + OFF_W_DN0), 1024, (const bf16_t*)(ws + OFF_HID), MT, DFF, smem, e);
  }
  if constexpr (PH == 7) {
    EpiQKV e{(bf16_t*)(ws + OFF_Q), (bf16_t*)(ws + OFF_K), (bf16_t*)(ws + OFF_VT), (const float2*)(ws + OFF_ROPE), 0.125f * 1.4426950408889634f};
    gemm_phase<256, 256, 2, 4, 2>(xb, MT, (const bf16_t*)(ws + OFF_W_QKV), 3072, 1024, smem, e);
  }
  if constexpr (PH == 8) phase_attn(p, smem);
  if constexpr (PH == 9) {
    EpiLN e{p.out, p.out, (bf16_t*)(ws + OFF_XB), p.mix_g + 1024, p.mix_b + 1024};
    gemm_phase<1024, 64, 8, 1, 1>((const bf16_t*)(ws + OFF_W_OUT1), 1024, mixb, MT, 1024, smem, e);
  }
  if constexpr (PH == 10) {
    EpiSwiGLU e{(bf16_t*)(ws + OFF_HID)};
    gemm_phase<256, 256, 2, 4, 2>(xb, MT, (const bf16_t*)(ws + OFF_W_GU1), 2 * DFF, 1024, smem, e);
  }
  if constexpr (PH == 11) {
    EpiLN e{p.out, p.out, (bf16_t*)(ws + OFF_XB), p.ffn_g + 1024, p.ffn_b + 1024};
    gemm_phase<1024, 64, 8, 1, 1>((const bf16_t*)(ws + OFF_W_DN1), 1024, (const bf16_t*)(ws + OFF_HID), MT, DFF, smem, e);
  }
}
template <int PH, int P1>
DI void run_from(const Params& p, char* smem) {
  run_phase<PH>(p, smem);
  if constexpr (PH + 1 < P1) {
    cg::this_grid().sync();
    run_from<PH + 1, P1>(p, smem);
  }
}
template <int P0, int P1>
__global__ void __launch_bounds__(NTHR) fwd_kernel(Params p) {
  __shared__ __attribute__((aligned(16))) char smem[139264];
  run_from<P0, P1>(p, smem);
}

typedef void (*kern_t)(Params);

extern "C" void kernel_launch(void* const* d_in, const int* in_sizes, int n_in, void* d_out, int out_size, void* d_ws, size_t ws_size, hipStream_t stream) {
  static int grid_blocks = 0;
  if (!grid_blocks) {
    int dev = 0, cus = 0, per_cu = 0;
    (void)hipGetDevice(&dev);
    (void)hipDeviceGetAttribute(&cus, hipDeviceAttributeMultiprocessorCount, dev);
#if MK_SINGLE
    (void)hipOccupancyMaxActiveBlocksPerMultiprocessor(&per_cu, fwd_kernel<0, 12>, NTHR, 0);
#else
    per_cu = 1;
#endif
    if (per_cu < 1) per_cu = 1;
    if (cus < 1) cus = 256;
    grid_blocks = cus * per_cu;
  }
  Params p{};
  const float** f = (const float**)&p;
  for (int i = 0; i < 29; ++i) f[i] = (const float*)d_in[i];
  p.out = (float*)d_out; p.ws = (char*)d_ws;
#if MK_SINGLE
  void* args[] = {&p};
  hipError_t e = hipLaunchCooperativeKernel((void*)fwd_kernel<0, 12>, dim3(grid_blocks), dim3(NTHR), args, 0, stream);
  if (e != hipSuccess) fprintf(stderr, "cooperative launch failed: %s (grid %d)\n", hipGetErrorString(e), grid_blocks);
#else
  static const kern_t ks[12] = {fwd_kernel<0, 1>, fwd_kernel<1, 2>, fwd_kernel<2, 3>, fwd_kernel<3, 4>, fwd_kernel<4, 5>, fwd_kernel<5, 6>,
                                fwd_kernel<6, 7>, fwd_kernel<7, 8>, fwd_kernel<8, 9>, fwd_kernel<9, 10>, fwd_kernel<10, 11>, fwd_kernel<11, 12>};
  for (int ph = 0; ph < 12; ++ph) hipLaunchKernelGGL(ks[ph], dim3(grid_blocks), dim3(NTHR), 0, stream, p);
#endif
}
```

```cpp
#include <hip/hip_runtime.h>
#include <hip/hip_cooperative_groups.h>
#include <cstdio>
#include <cstdint>
namespace cg = cooperative_groups;

#ifndef MK_SINGLE
#define MK_SINGLE 1
#endif
#ifndef DUP_MASK
#define DUP_MASK 0
#endif
#ifndef ATTN_VAR
#define ATTN_VAR 0
#endif
#ifndef P2_VAR
#define P2_VAR 0
#endif

typedef unsigned short bf16_t;
typedef short bf16x8 __attribute__((ext_vector_type(8)));
typedef float f32x16 __attribute__((ext_vector_type(16)));
typedef __bf16 bf16x2_t __attribute__((ext_vector_type(2)));
typedef float f32x2_t __attribute__((ext_vector_type(2)));
typedef unsigned u32x4 __attribute__((ext_vector_type(4)));
#define DI __device__ __forceinline__
#define MFMA(a, b, c) __builtin_amdgcn_mfma_f32_32x32x16_bf16((a), (b), (c), 0, 0, 0)

constexpr int MT = 16384;
constexpr int DM = 1024;
constexpr int SEQ = 2048;
constexpr int DFF = 2816;
constexpr int NTHR = 512;
constexpr float LN_EPS = 1e-5f;
constexpr float DN_ALPHA = 1.4142135623730951f;
constexpr float LAMBDA_INIT = 0.35550906759096926f;

constexpr size_t MB = 1024 * 1024;
constexpr size_t OFF_W_IN = 0;
constexpr size_t OFF_W_OUT0 = OFF_W_IN + 4 * MB;
constexpr size_t OFF_W_GU0 = OFF_W_OUT0 + 2 * MB;
constexpr size_t OFF_W_DN0 = OFF_W_GU0 + (size_t)5632 * 1024 * 2;
constexpr size_t OFF_W_QKV = OFF_W_DN0 + (size_t)2816 * 1024 * 2;
constexpr size_t OFF_W_OUT1 = OFF_W_QKV + 6 * MB;
constexpr size_t OFF_W_GU1 = OFF_W_OUT1 + 2 * MB;
constexpr size_t OFF_W_DN1 = OFF_W_GU1 + (size_t)5632 * 1024 * 2;
constexpr size_t OFF_XB = OFF_W_DN1 + (size_t)2816 * 1024 * 2;
constexpr size_t OFF_MIX = OFF_XB + 32 * MB;
constexpr size_t OFF_REGA = OFF_MIX + 32 * MB;
constexpr size_t OFF_GB = OFF_REGA + 16 * MB;
constexpr size_t OFF_HLOC = OFF_REGA + 48 * MB;
constexpr size_t OFF_HID = OFF_REGA;
constexpr size_t OFF_Q = OFF_REGA;
constexpr size_t OFF_K = OFF_REGA + 32 * MB;
constexpr size_t OFF_VT = OFF_REGA + 64 * MB;
constexpr size_t OFF_PBUF = OFF_REGA + 96 * MB;
constexpr size_t OFF_GLU = OFF_PBUF;
constexpr size_t OFF_RB = OFF_PBUF + 16 * MB;
constexpr size_t OFF_AGG = OFF_PBUF + 32 * MB;
constexpr size_t OFF_ROPE = OFF_AGG + 2 * MB;
constexpr size_t OFF_BAR = OFF_ROPE + 1 * MB;
constexpr size_t OFF_PART = OFF_BAR + 1 * MB;
constexpr size_t OFF_WT = OFF_PART + 2 * MB;

struct Params {
  const float* x; const float* w_in; const float* b_in; const float* conv_w; const float* conv_b;
  const float* cn_g; const float* cn_b; const float* lconv_w; const float* lconv_b;
  const float* w_a; const float* b_a; const float* w_x; const float* b_x; const float* lru_lam; const float* w_out0;
  const float* w_qkv; const float* lq1; const float* lk1; const float* lq2; const float* lk2; const float* subln_g; const float* w_out1;
  const float* mix_g; const float* mix_b; const float* ffn_gate; const float* ffn_up; const float* ffn_down;
  const float* ffn_g; const float* ffn_b;
  float* out; char* ws;
};

DI unsigned pk2(float lo, float hi) { f32x2_t v = {lo, hi}; bf16x2_t b = __builtin_convertvector(v, bf16x2_t); return __builtin_bit_cast(unsigned, b); }
DI bf16_t f2bf(float x) { return (bf16_t)(pk2(x, 0.f) & 0xffffu); }
DI float bf2f(bf16_t b) { return __uint_as_float(((unsigned)b) << 16); }
DI int crow(int i, int h) { return (i & 3) + 8 * (i >> 2) + 4 * h; }
DI float sigmoid_(float x) { return __builtin_amdgcn_rcpf(1.f + __expf(-x)); }
DI float silu_(float x) { return x * sigmoid_(x); }
DI float gelu_tanh(float x) {
  float y = 0.7978845608028654f * (x + 0.044715f * x * x * x);
  float t = 1.f - 2.f * __builtin_amdgcn_rcpf(1.f + __expf(2.f * y));
  return 0.5f * x * (1.f + t);
}
DI unsigned lds_off(int row, int chunk) { return (unsigned)(row * 64 + (((chunk ^ (row >> 2)) & 3) << 4)); }
DI float xor_lane(float v, int mask, int lane) { return __int_as_float(__builtin_amdgcn_ds_bpermute((lane ^ mask) << 2, __float_as_int(v))); }
DI float half_max(float v) { auto r = __builtin_amdgcn_permlane32_swap(__float_as_uint(v), __float_as_uint(v), false, false); return fmaxf(__uint_as_float(r[0]), __uint_as_float(r[1])); }
DI float half_sum(float v) { auto r = __builtin_amdgcn_permlane32_swap(__float_as_uint(v), __float_as_uint(v), false, false); return __uint_as_float(r[0]) + __uint_as_float(r[1]); }
template <int CTRL, int ROW_MASK>
DI float dpp_add(float v) {
  return v + __int_as_float(__builtin_amdgcn_update_dpp(0, __float_as_int(v), CTRL, ROW_MASK, 0xf, false));
}
DI float wave_sum(float v, int  ) {
  v = dpp_add<0xB1, 0xf>(v);
  v = dpp_add<0x4E, 0xf>(v);
  v = dpp_add<0x141, 0xf>(v);
  v = dpp_add<0x140, 0xf>(v);
  v = dpp_add<0x142, 0xa>(v);
  v = dpp_add<0x143, 0xc>(v);
  return __int_as_float(__builtin_amdgcn_readlane(__float_as_int(v), 63));
}

DI void cvt_weight(bf16_t* __restrict__ dst, const float* __restrict__ s0, const float* __restrict__ s1,
                   int K, int Nsrc, int Np, int mode, int gtid, int gsz, char* smem) {
  const int total = (K / 32) * Np;
  const int lane = gtid & 63;
  char* wbuf = smem + ((gtid >> 6) & 7) * 4096;
  for (int idx = gtid; idx < total; idx += gsz) {
    const int kg = idx / Np, np = idx - kg * Np;
    const float* src = s0; int n = np;
    if (mode == 1) {
      const int blk = np >> 6, t = np & 63;
      if (blk < 16) n = (t < 32) ? (blk * 32 + t) : (512 + blk * 32 + (t - 32));
      else { const int j = blk - 16; n = (t < 32) ? (1024 + j * 32 + t) : (1536 + j * 32 + (t - 32)); }
    } else if (mode == 2) {
      const int blk = np >> 6, t = np & 63;
      src = (t < 32) ? s0 : s1; n = blk * 32 + (t & 31);
    }
    const float* p = src + (size_t)(kg * 32) * Nsrc + n;
    unsigned o[16];
#pragma unroll
    for (int kk = 0; kk < 16; ++kk) o[kk] = pk2(p[(size_t)(2 * kk) * Nsrc], p[(size_t)(2 * kk + 1) * Nsrc]);
#pragma unroll
    for (int e = 0; e < 4; ++e) *(u32x4*)(wbuf + lane * 64 + e * 16) = (u32x4){o[4 * e], o[4 * e + 1], o[4 * e + 2], o[4 * e + 3]};
    __builtin_amdgcn_wave_barrier();
    asm volatile("s_waitcnt lgkmcnt(0)" ::: "memory");
    char* d = (char*)(dst + (size_t)(idx - lane) * 32);
#pragma unroll
    for (int e = 0; e < 4; ++e) *(u32x4*)(d + e * 1024 + lane * 16) = *(const u32x4*)(wbuf + e * 1024 + lane * 16);
    __builtin_amdgcn_wave_barrier();
  }
}

DI void phase_prep(const Params& p, char* smem) {
  int tid0 = threadIdx.x;
  asm volatile("" : "+v"(tid0));
  const int gtid = blockIdx.x * NTHR + tid0, gsz = gridDim.x * NTHR;
  char* ws = p.ws;
  {
    bf16_t* xb = (bf16_t*)(ws + OFF_XB);
    for (int idx = gtid; idx < MT * 32; idx += gsz) {
      const int kg = idx >> 14, row = idx & (MT - 1);
      const float4* s = (const float4*)(p.x + (size_t)row * DM + kg * 32);
      uint4* d = (uint4*)(xb + ((size_t)kg * MT + row) * 32);
#pragma unroll
      for (int e = 0; e < 4; ++e) {
        float4 a = s[2 * e], b = s[2 * e + 1];
        d[e] = make_uint4(pk2(a.x, a.y), pk2(a.z, a.w), pk2(b.x, b.y), pk2(b.z, b.w));
      }
    }
  }
  cvt_weight((bf16_t*)(ws + OFF_W_IN), p.w_in, p.w_in, 1024, 2048, 2048, 1, gtid, gsz, smem);
  cvt_weight((bf16_t*)(ws + OFF_W_OUT0), p.w_out0, p.w_out0, 1024, 1024, 1024, 0, gtid, gsz, smem);
  cvt_weight((bf16_t*)(ws + OFF_W_GU0), p.ffn_gate, p.ffn_up, 1024, DFF, 2 * DFF, 2, gtid, gsz, smem);
  cvt_weight((bf16_t*)(ws + OFF_W_DN0), p.ffn_down, p.ffn_down, DFF, 1024, 1024, 0, gtid, gsz, smem);
  cvt_weight((bf16_t*)(ws + OFF_W_QKV), p.w_qkv, p.w_qkv, 1024, 3072, 3072, 0, gtid, gsz, smem);
  cvt_weight((bf16_t*)(ws + OFF_W_OUT1), p.w_out1, p.w_out1, 1024, 1024, 1024, 0, gtid, gsz, smem);
  cvt_weight((bf16_t*)(ws + OFF_W_GU1), p.ffn_gate + (size_t)1024 * DFF, p.ffn_up + (size_t)1024 * DFF, 1024, DFF, 2 * DFF, 2, gtid, gsz, smem);
  cvt_weight((bf16_t*)(ws + OFF_W_DN1), p.ffn_down + (size_t)DFF * 1024, p.ffn_down + (size_t)DFF * 1024, DFF, 1024, 1024, 0, gtid, gsz, smem);
  {
    bf16_t* wt = (bf16_t*)(ws + OFF_WT);
    for (int idx = gtid; idx < 2 * 8 * 64 * 8; idx += gsz) {
      const int i8 = idx & 7, j = (idx >> 3) & 63, g = (idx >> 9) & 7, gate = idx >> 12;
      const float* w = (gate ? p.w_x : p.w_a) + (size_t)(g * 64 + i8 * 8) * 64 + j;
      uint4 o = make_uint4(pk2(w[0], w[64]), pk2(w[128], w[192]), pk2(w[256], w[320]), pk2(w[384], w[448]));
      *(uint4*)(wt + (size_t)idx * 8) = o;
    }
  }
  {
    float2* tab = (float2*)(ws + OFF_ROPE);
    for (int idx = gtid; idx < SEQ * 32; idx += gsz) {
      const int pos = idx >> 5, j = idx & 31;
      const float inv = powf(10000.0f, -(float)j / 32.0f);
      const float ang = (float)pos * inv;
      double t = (double)ang * 0.15915494309189535;
      t -= rint(t);
      const float tf = (float)t;
      tab[idx] = make_float2(__builtin_amdgcn_cosf(tf), __builtin_amdgcn_sinf(tf));
    }
  }
}

#define WAITV(n) asm volatile("s_waitcnt vmcnt(" #n ")" ::: "memory")
template <int BM, int BN, int WR, int WC, int G, bool T2MAJOR, class Epi>
DI void gemm_phase(const bf16_t* __restrict__ P1, int R1, const bf16_t* __restrict__ P2, int R2, int K, char* smem, const Epi& epi, int tile_begin = 0, int tile_end = -1) {
  constexpr int MI = BM / WR / 32, NI = BN / WC / 32;
  static_assert((MI == 4 || MI == 2) && NI == 2 && (BM == 256 || BM == 128) && BN == 256, "256 (or 128) x 256 tile, wave tile 128 (or 64) x 64");
  constexpr int SPLIT = 256 / BM;
  constexpr int NDMA = (BM + BN) / 128;
  constexpr int STAGE = (BM + BN) * 64;
  int tid = threadIdx.x;
  asm volatile("" : "+v"(tid));
  const int lane = tid & 63, wave = __builtin_amdgcn_readfirstlane(tid >> 6);
  const int wr = wave / WC, wc = wave % WC;
  const int l32 = lane & 31, h = lane >> 5;
  const int tiles2 = R2 / BN, ntiles = (R1 / 256) * tiles2;
  if (tile_end < 0) tile_end = ntiles;
  const int KT = K / 32;
  const int srow = tid >> 2, schunk = (tid & 3) ^ ((tid >> 4) & 3);
  const unsigned soff = (unsigned)(srow * 32 + schunk * 8);
  const int tiles1 = R1 / 256;
  const bool xcd_order = (gridDim.x == 256) && (tiles1 % 64 == 0);
  const int ppx = tiles1 / 8;
  auto tile_origin = [&](int tile0, int& o1, int& o2) __attribute__((always_inline)) {
    int t1, t2;
    if (xcd_order) {
      const int xcd = tile0 & 7, lt = tile0 >> 3;
      const int grp = lt / (ppx * 4), rem = lt - grp * (ppx * 4);
      t2 = grp * 4 + rem / ppx; t1 = xcd * ppx + rem % ppx;
    } else {
      t1 = T2MAJOR ? (tile0 % tiles1) : (tile0 / tiles2); t2 = T2MAJOR ? (tile0 / tiles1) : (tile0 - t1 * tiles2);
    }
    o1 = t1 * 256; o2 = t2 * BN;
  };
  auto issue = [&](int kt, int o1, int o2) __attribute__((always_inline)) {
    const bf16_t* a1 = P1 + ((size_t)kt * R1 + o1) * 32;
    const bf16_t* a2 = P2 + ((size_t)kt * R2 + o2) * 32;
    char* l = smem + (kt & 3) * STAGE + tid * 16;
#pragma unroll
    for (int i = 0; i < BM / 128; ++i)
      __builtin_amdgcn_global_load_lds((const unsigned*)(a1 + i * 128 * 32 + soff), (__attribute__((address_space(3))) unsigned*)(l + i * 8192), 16, 0, 0);
#pragma unroll
    for (int i = 0; i < BN / 128; ++i)
      __builtin_amdgcn_global_load_lds((const unsigned*)(a2 + i * 128 * 32 + soff), (__attribute__((address_space(3))) unsigned*)(l + BM * 64 + i * 8192), 16, 0, 0);
  };
  bool pref = false;
  for (int u = tile_begin * SPLIT + blockIdx.x; u < tile_end * SPLIT; u += gridDim.x) {
    int o1, o2;
    int ut = u / SPLIT, uh = u % SPLIT;
    if (SPLIT == 2 && xcd_order && (tile_end - tile_begin) * 2 == 256) {
      const int v = u - tile_begin * SPLIT, xcd = v & 7, j = (v >> 3) & 7, m = v >> 6;
      ut = xcd + 8 * ((tile_begin >> 3) + (m >> 1) * 8 + j); uh = m & 1;
    }
    tile_origin(ut, o1, o2);
    o1 += uh * BM;

    f32x16 acc[MI][NI];
#pragma unroll
    for (int mi = 0; mi < MI; ++mi)
#pragma unroll
      for (int ni = 0; ni < NI; ++ni)
#pragma unroll
        for (int i = 0; i < 16; ++i) acc[mi][ni][i] = 0.f;

    if (!pref) {
      __syncthreads();
      issue(0, o1, o2); issue(1, o1, o2); issue(2, o1, o2);
      if constexpr (NDMA == 4) WAITV(8); else WAITV(6);
    } else {
      WAITV(0);
    }
    __builtin_amdgcn_s_barrier();
    if (wr == 1) __builtin_amdgcn_s_barrier();
    __builtin_amdgcn_sched_barrier(0);
    for (int kt = 0; kt < KT; ++kt) {
      const char* base = smem + (kt & 3) * STAGE;
#pragma unroll
      for (int ks = 0; ks < 2; ++ks) {
        const int chunk = ks * 2 + h;
        bf16x8 a[MI], b[NI];
#pragma unroll
        for (int mi = 0; mi < MI; ++mi) a[mi] = *(const bf16x8*)(base + lds_off(wr * (BM / WR) + mi * 32 + l32, chunk));
#pragma unroll
        for (int ni = 0; ni < NI; ++ni) b[ni] = *(const bf16x8*)(base + lds_off(BM + wc * (BN / WC) + ni * 32 + l32, chunk));
        if (ks == 1) {
          if (kt + 3 < KT) { issue(kt + 3, o1, o2); if constexpr (NDMA == 4) WAITV(8); else WAITV(6); }
          else if (kt + 2 < KT) { if constexpr (NDMA == 4) WAITV(4); else WAITV(3); }
          else WAITV(0);
        }
        __builtin_amdgcn_sched_barrier(0);
        __builtin_amdgcn_s_barrier();
        __builtin_amdgcn_sched_barrier(0);
        __builtin_amdgcn_s_setprio(1);
#pragma unroll
        for (int mi = 0; mi < MI; ++mi)
#pragma unroll
          for (int ni = 0; ni < NI; ++ni) acc[mi][ni] = MFMA(a[mi], b[ni], acc[mi][ni]);
        __builtin_amdgcn_s_setprio(0);
        __builtin_amdgcn_sched_barrier(0);
        __builtin_amdgcn_s_barrier();
        __builtin_amdgcn_sched_barrier(0);
      }
    }
    if (wr == 0) __builtin_amdgcn_s_barrier();
    __syncthreads();
    pref = false;
    if (!Epi::kUsesSmem && u + (int)gridDim.x < tile_end * SPLIT) {
      int n1, n2;
      tile_origin((u + (int)gridDim.x) / SPLIT, n1, n2);
      n1 += ((u + (int)gridDim.x) % SPLIT) * BM;
      issue(0, n1, n2); issue(1, n1, n2); issue(2, n1, n2);
      pref = true;
    }
    int lane_e = lane;
    asm volatile("" : "+v"(lane_e));
    epi(acc, o1 + wr * (BM / WR), o2 + wc * (BN / WC), lane_e, smem);
  }
}

struct EpiInProj {
  static constexpr bool kUsesSmem = false;
  const float* b_in; bf16_t* glu; bf16_t* gb; bf16_t* rb;
  DI void operator()(f32x16 (&acc)[4][2], int row0, int col0, int lane, char* smem) const {
    const int l32 = lane & 31, h = lane >> 5;
    const int blk = col0 >> 6;
    const bool isA = blk < 16;
    const int ch = (isA ? blk : blk - 16) * 32 + l32;
    const float b0 = b_in[(isA ? 0 : 1024) + ch], b1 = b_in[(isA ? 512 : 1536) + ch];
    if (isA) {
#pragma unroll
      for (int mi = 0; mi < 4; ++mi)
#pragma unroll
        for (int i = 0; i < 16; ++i) {
          const size_t row = row0 + mi * 32 + crow(i, h);
          const float v0 = acc[mi][0][i] + b0, v1 = acc[mi][1][i] + b1;
          glu[row * 512 + ch] = f2bf(v0 * sigmoid_(v1));
        }
    } else {
      const int wave = (int)__builtin_amdgcn_readfirstlane((int)(threadIdx.x >> 6));
      char* wbuf = smem + 131072 + wave * 4096;
      const size_t kg = (size_t)((512 + (blk - 16) * 32) >> 5);
#pragma unroll
      for (int mp = 0; mp < 2; ++mp) {
#pragma unroll
        for (int mm = 0; mm < 2; ++mm)
#pragma unroll
          for (int i = 0; i < 16; ++i) {
            const int mi = mp * 2 + mm;
            const size_t row = row0 + mi * 32 + crow(i, h);
            const float v0 = acc[mi][0][i] + b0, v1 = acc[mi][1][i] + b1;
            *(bf16_t*)(wbuf + (mm * 32 + crow(i, h)) * 64 + l32 * 2) = f2bf(gelu_tanh(v0));
            rb[row * 512 + ch] = f2bf(v1);
          }
        __builtin_amdgcn_wave_barrier();
        asm volatile("s_waitcnt lgkmcnt(0)" ::: "memory");
        char* d = (char*)(gb + (kg * MT + row0 + mp * 64) * 32);
#pragma unroll
        for (int e = 0; e < 4; ++e) *(u32x4*)(d + e * 1024 + lane * 16) = *(const u32x4*)(wbuf + e * 1024 + lane * 16);
        __builtin_amdgcn_wave_barrier();
      }
    }
  }
};
struct EpiSwiGLU {
  static constexpr bool kUsesSmem = false;
  bf16_t* hid;
  template <int MI>
  DI void operator()(f32x16 (&acc)[MI][2], int row0, int col0, int lane, char* smem) const {
    const int l32 = lane & 31, h = lane >> 5;
    const int wave = (int)__builtin_amdgcn_readfirstlane((int)(threadIdx.x >> 6));
    const size_t kg = col0 >> 6;
    char* wbuf = smem + 131072 + wave * 4096;
#pragma unroll
    for (int mp = 0; mp < MI / 2; ++mp) {
#pragma unroll
      for (int mm = 0; mm < 2; ++mm)
#pragma unroll
        for (int i = 0; i < 16; ++i) {
          const int r = mm * 32 + crow(i, h);
          *(bf16_t*)(wbuf + r * 64 + l32 * 2) = f2bf(silu_(acc[mp * 2 + mm][0][i]) * acc[mp * 2 + mm][1][i]);
        }
      __builtin_amdgcn_wave_barrier();
      asm volatile("s_waitcnt lgkmcnt(0)" ::: "memory");
      char* d = (char*)(hid + (kg * MT + row0 + mp * 64) * 32);
#pragma unroll
      for (int e = 0; e < 4; ++e) *(u32x4*)(d + e * 1024 + lane * 16) = *(const u32x4*)(wbuf + e * 1024 + lane * 16);
      __builtin_amdgcn_wave_barrier();
    }
  }
};
struct EpiQKV {
  static constexpr bool kUsesSmem = false;
  bf16_t* q; bf16_t* k; bf16_t* vt; const float2* rope; float qscale;
  DI void operator()(f32x16 (&acc)[4][2], int row0, int col0, int lane, char*) const {
    const int l32 = lane & 31, h = lane >> 5;
    const int sect = col0 >> 10, within = col0 & 1023, head = within >> 7;
    const int b = row0 >> 11;
    if (sect < 2) {
      const int m = (within >> 6) & 1;
      bf16_t* dst = (sect == 0) ? q : k;
      const float sc = (sect == 0) ? qscale : 1.f;
      const size_t base0 = ((size_t)((b * 8 + head) * 2 + m) * 2 + 0) * SEQ;
      const size_t base1 = ((size_t)((b * 8 + head) * 2 + m) * 2 + 1) * SEQ;
#pragma unroll
      for (int mi = 0; mi < 4; ++mi)
#pragma unroll
        for (int i = 0; i < 16; ++i) {
          const int pos = ((row0 + mi * 32) & (SEQ - 1)) + crow(i, h);
          const float2 cs = rope[pos * 32 + l32];
          const float lo = acc[mi][0][i], hi = acc[mi][1][i];
          const float olo = (lo * cs.x - hi * cs.y) * sc, ohi = (hi * cs.x + lo * cs.y) * sc;
          dst[(base0 + pos) * 32 + l32] = f2bf(olo);
          dst[(base1 + pos) * 32 + l32] = f2bf(ohi);
        }
    } else {
      const int vd0 = within & 127;
#pragma unroll
      for (int mi = 0; mi < 4; ++mi) {
        const int pos0 = (row0 + mi * 32) & (SEQ - 1);
        const size_t sg = pos0 >> 5;
#pragma unroll
        for (int ni = 0; ni < 2; ++ni) {
          const int vdim = vd0 + ni * 32 + l32;
          bf16_t* d = vt + (((size_t)(b * 8 + head) * 64 + sg) * 128 + vdim) * 32;
#pragma unroll
          for (int jq = 0; jq < 4; ++jq) {
            const int ppos = 16 * (jq >> 1) + 8 * h + 4 * (jq & 1);
            uint2 v = make_uint2(pk2(acc[mi][ni][4 * jq], acc[mi][ni][4 * jq + 1]), pk2(acc[mi][ni][4 * jq + 2], acc[mi][ni][4 * jq + 3]));
            *(uint2*)(d + ppos) = v;
          }
        }
      }
    }
  }
};
template <int X> DI float swz_xor(float v) { return __int_as_float(__builtin_amdgcn_ds_swizzle(__float_as_int(v), 0x1f | (X << 10))); }
DI void reduce_scatter32(float (&v)[32], int l32) {
  { const bool up = (l32 & 16) != 0;
#pragma unroll
    for (int j = 0; j < 16; ++j) { const float keep = up ? v[j + 16] : v[j], send = up ? v[j] : v[j + 16]; v[j] = keep + swz_xor<16>(send); } }
  { const bool up = (l32 & 8) != 0;
#pragma unroll
    for (int j = 0; j < 8; ++j) { const float keep = up ? v[j + 8] : v[j], send = up ? v[j] : v[j + 8]; v[j] = keep + swz_xor<8>(send); } }
  { const bool up = (l32 & 4) != 0;
#pragma unroll
    for (int j = 0; j < 4; ++j) { const float keep = up ? v[j + 4] : v[j], send = up ? v[j] : v[j + 4]; v[j] = keep + swz_xor<4>(send); } }
  { const bool up = (l32 & 2) != 0;
#pragma unroll
    for (int j = 0; j < 2; ++j) { const float keep = up ? v[j + 2] : v[j], send = up ? v[j] : v[j + 2]; v[j] = keep + swz_xor<2>(send); } }
  { const bool up = (l32 & 1) != 0;
    const float keep = up ? v[1] : v[0], send = up ? v[0] : v[1]; v[0] = keep + swz_xor<1>(send); }
}
template <bool FINAL>
struct EpiLN {
  static constexpr bool kUsesSmem = true;
  float* outf; bf16_t* xb; const float* g; const float* bt; float* part; unsigned* flag; int dry; int pass;
  DI void operator()(f32x16 (&acc)[4][2], int row0, int col0, int lane, char* smem) const {
    const int l32 = lane & 31, h = lane >> 5;
    const int wave = (int)__builtin_amdgcn_readfirstlane((int)(threadIdx.x >> 6));
    const int tid_e = wave * 64 + lane;
    const int tb = row0 >> 8, wr = (row0 >> 7) & 1, fb = col0 >> 8, wc = (col0 >> 6) & 3;
    float* T = (float*)smem;
    float2* sred = (float2*)(smem + 131072);
    float2* sstat = (float2*)(smem + 133120);
    const size_t colg = (size_t)fb * 256 + lane * 4;
    bf16_t* xq = xb + ((size_t)(fb * 8 + (lane >> 3)) * MT) * 32 + (lane & 7) * 4;
#pragma unroll 1
    for (int hh = 0; hh < 2; ++hh) {
      uint2 rres[16];
      {
        const bf16_t* xr = xq + ((size_t)tb * 256 + hh * 128 + wave * 16) * 32;
#pragma unroll
        for (int rr = 0; rr < 16; ++rr) rres[rr] = *(const uint2*)(xr + rr * 32);
      }
      if (wr == hh) {
        float* tw = T + (4 * h) * 256 + wc * 64 + l32;
#pragma unroll
        for (int mi = 0; mi < 4; ++mi)
#pragma unroll
          for (int i = 0; i < 16; ++i) {
            const int rc = mi * 32 + 8 * (i >> 2) + (i & 3);
            tw[rc * 256] = acc[mi][0][i];
            tw[rc * 256 + 32] = acc[mi][1][i];
          }
      }
      __syncthreads();
#pragma unroll
      for (int rr = 0; rr < 16; ++rr) {
        const int rl = wave * 16 + rr;
        const float4 a = *(const float4*)(T + rl * 256 + lane * 4);
        const uint2 rv = rres[rr];
        float4 z;
        z.x = a.x + DN_ALPHA * __uint_as_float(rv.x << 16); z.y = a.y + DN_ALPHA * __uint_as_float(rv.x & 0xffff0000u);
        z.z = a.z + DN_ALPHA * __uint_as_float(rv.y << 16); z.w = a.w + DN_ALPHA * __uint_as_float(rv.y & 0xffff0000u);
        *(float4*)(T + rl * 256 + lane * 4) = z;
        float s = (z.x + z.y) + (z.z + z.w), q = (z.x * z.x + z.y * z.y) + (z.z * z.z + z.w * z.w);
        s = wave_sum(s, lane); q = wave_sum(q, lane);
        if (lane == 0) sred[rl] = make_float2(s, q);
      }
      __syncthreads();
      if (tid_e < 128) {
        const float2 sv = sred[tid_e];
        const unsigned long long bits = ((unsigned long long)__float_as_uint(sv.y) << 32) | __float_as_uint(sv.x);
        __hip_atomic_store((unsigned long long*)(part + ((size_t)(tb * 4 + fb) * 256 + hh * 128 + tid_e) * 2), bits, __ATOMIC_RELAXED, __HIP_MEMORY_SCOPE_AGENT);
        asm volatile("s_waitcnt vmcnt(0)" ::: "memory");
      }
      __syncthreads();
      if (tid_e == 0) {
        __hip_atomic_fetch_add(flag + tb, 1u, __ATOMIC_RELAXED, __HIP_MEMORY_SCOPE_AGENT);
        while (__hip_atomic_load(flag + tb, __ATOMIC_RELAXED, __HIP_MEMORY_SCOPE_AGENT) < 4u * (hh + 1) + 8u * (unsigned)pass) __builtin_amdgcn_s_sleep(1);
      }
      __syncthreads();
      if (tid_e < 128) {
        float a = 0.f, a2 = 0.f;
#pragma unroll
        for (int j = 0; j < 4; ++j) {
          const unsigned long long bits = __hip_atomic_load((const unsigned long long*)(part + ((size_t)(tb * 4 + j) * 256 + hh * 128 + tid_e) * 2), __ATOMIC_RELAXED, __HIP_MEMORY_SCOPE_AGENT);
          a += __uint_as_float((unsigned)bits); a2 += __uint_as_float((unsigned)(bits >> 32));
        }
        const float mean = a * (1.f / 1024.f);
        const float var = fmaxf(a2 * (1.f / 1024.f) - mean * mean, 0.f);
        sstat[tid_e] = make_float2(mean, rsqrtf(var + LN_EPS));
      }
      __syncthreads();
      const float4 gg = *(const float4*)(g + colg), bb = *(const float4*)(bt + colg);
#pragma unroll 1
      for (int rr = 0; rr < 16; ++rr) {
        const int rl = wave * 16 + rr;
        const size_t row = (size_t)tb * 256 + hh * 128 + rl;
        const float2 st = sstat[rl];
        const float4 z = *(const float4*)(T + rl * 256 + lane * 4);
        float4 o;
        o.x = (z.x - st.x) * st.y * gg.x + bb.x; o.y = (z.y - st.x) * st.y * gg.y + bb.y;
        o.z = (z.z - st.x) * st.y * gg.z + bb.z; o.w = (z.w - st.x) * st.y * gg.w + bb.w;
        if (FINAL) *(float4*)(outf + row * DM + colg) = o;
        else if (!dry) *(uint2*)(xq + row * 32) = make_uint2(pk2(o.x, o.y), pk2(o.z, o.w));
      }
      __syncthreads();
    }
  }
};

template <int VAR>
DI void phase_convlru(const Params& p, char* smem) {
  int tid = threadIdx.x;
  asm volatile("" : "+v"(tid));
  const int lane = tid & 63, wave = tid >> 6;
  const int c = tid;
  char* ws = p.ws;
  const bf16_t* glu = (const bf16_t*)(ws + OFF_GLU);
  const bf16_t* rbuf = (const bf16_t*)(ws + OFF_RB);
  const bf16_t* gbuf = (const bf16_t*)(ws + OFF_GB);
  float2* agg = (float2*)(ws + OFF_AGG);
  unsigned* lflag = (unsigned*)(ws + OFF_BAR) + 512;
  bf16_t* mix = (bf16_t*)(ws + (VAR ? OFF_HLOC : OFF_MIX));
  bf16_t* sA = (bf16_t*)smem;
  float* sOut = (float*)(smem + 63488);
  bf16_t* sR = (bf16_t*)smem;
  constexpr int RS = 516;
  float* sRf = (float*)(smem + 36864);

  const bool own_batch = (gridDim.x == 256);
  for (int it = blockIdx.x; it < 512; it += gridDim.x) {
    const int item = own_batch ? (((it & 7) << 6) | ((it >> 3) & 31) | ((it >> 8) << 5)) : it;
    const int b = item >> 6, ft = item & 63, t0 = ft * 32;
    const size_t rowbase = (size_t)b * SEQ;
    __syncthreads();
    if (VAR != 1) {
    for (int q = tid; q < 62 * 64; q += NTHR) {
      const int r = q >> 6, cc = q & 63, fr = t0 - 30 + r;
      uint4 v = make_uint4(0, 0, 0, 0);
      if (fr >= 0) v = *(const uint4*)(glu + (rowbase + fr) * 512 + cc * 8);
      *(uint4*)(sA + r * 512 + cc * 8) = v;
    }
    __syncthreads();
    {
      int cq = c;
      asm volatile("" : "+v"(cq));
      float cw[31];
#pragma unroll
      for (int j = 0; j < 31; ++j) cw[j] = p.conv_w[j * 512 + cq];
      const float cb = p.conv_b[cq];
      float xin[62];
#pragma unroll
      for (int r = 0; r < 62; ++r) xin[r] = bf2f(sA[r * 512 + c]);
#pragma unroll
      for (int t = 0; t < 32; ++t) {
        float a = cb;
#pragma unroll
        for (int j = 0; j < 31; ++j) a += cw[j] * xin[t + j];
        sOut[t * 512 + c] = a;
      }
    }
    __syncthreads();
    for (int t = wave; t < 32; t += 8) {
      float v[8]; float s = 0.f;
#pragma unroll
      for (int e = 0; e < 8; ++e) { v[e] = sOut[t * 512 + e * 64 + lane]; s += v[e]; }
      s = wave_sum(s, lane);
      const float mean = s * (1.f / 512.f);
      float s2 = 0.f;
#pragma unroll
      for (int e = 0; e < 8; ++e) { const float d = v[e] - mean; s2 += d * d; }
      s2 = wave_sum(s2, lane);
      const float rstd = rsqrtf(s2 * (1.f / 512.f) + LN_EPS);
      const size_t row = rowbase + t0 + t;
#pragma unroll
      for (int e = 0; e < 8; ++e) {
        const int ch = e * 64 + lane;
        const float y = (v[e] - mean) * rstd * p.cn_g[ch] + p.cn_b[ch];
        mix[((size_t)(ch >> 5) * MT + row) * 32 + (ch & 31)] = f2bf(silu_(y));
      }
    }
    __syncthreads();
    }
    if (VAR != 2) {
    for (int q = tid; q < 35 * 64; q += NTHR) {
      const int r = q >> 6, cc = q & 63, fr = t0 - 3 + r;
      uint4 v = make_uint4(0, 0, 0, 0);
      if (fr >= 0) v = *(const uint4*)(rbuf + (rowbase + fr) * 512 + cc * 8);
      *(uint4*)(sR + r * 512 + cc * 8) = v;
    }
    __syncthreads();
    {
      const float w0 = p.lconv_w[c], w1 = p.lconv_w[512 + c], w2 = p.lconv_w[1024 + c], w3 = p.lconv_w[1536 + c];
      const float lb = p.lconv_b[c];
      for (int t = 0; t < 32; ++t) {
        float a = lb;
        a += w0 * bf2f(sR[(t + 0) * 512 + c]);
        a += w1 * bf2f(sR[(t + 1) * 512 + c]);
        a += w2 * bf2f(sR[(t + 2) * 512 + c]);
        a += w3 * bf2f(sR[(t + 3) * 512 + c]);
        sRf[t * RS + c] = a;
      }
    }
    __syncthreads();
    {
      const int g = wave, l32 = lane & 31, h = lane >> 5;
      const bf16_t* wt = (const bf16_t*)(ws + OFF_WT);
      bf16x8 af[4];
#pragma unroll
      for (int ks = 0; ks < 4; ++ks) {
        const float4 lo = *(const float4*)(sRf + l32 * RS + g * 64 + ks * 16 + 8 * h);
        const float4 hi = *(const float4*)(sRf + l32 * RS + g * 64 + ks * 16 + 8 * h + 4);
        const u32x4 pw = {pk2(lo.x, lo.y), pk2(lo.z, lo.w), pk2(hi.x, hi.y), pk2(hi.z, hi.w)};
        af[ks] = __builtin_bit_cast(bf16x8, pw);
      }
      f32x16 ga[2][2];
#pragma unroll
      for (int gate = 0; gate < 2; ++gate)
#pragma unroll
        for (int nt = 0; nt < 2; ++nt) {
#pragma unroll
          for (int i = 0; i < 16; ++i) ga[gate][nt][i] = 0.f;
#pragma unroll
          for (int ks = 0; ks < 4; ++ks) {
            const bf16x8 bfrag = *(const bf16x8*)(wt + ((size_t)((gate * 8 + g) * 64 + nt * 32 + l32)) * 64 + ks * 16 + 8 * h);
            ga[gate][nt] = MFMA(af[ks], bfrag, ga[gate][nt]);
          }
        }
      float av[2][16], uv[2][16];
#pragma unroll
      for (int nt = 0; nt < 2; ++nt) {
        const int cc = g * 64 + nt * 32 + l32;
        const float ba = p.b_a[cc], bx = p.b_x[cc];
        const float sp = log1pf(__expf(-p.lru_lam[cc]));
#pragma unroll
        for (int i = 0; i < 16; ++i) {
          const int t = crow(i, h);
          const float rme = sRf[t * RS + cc];
          const float gr = sigmoid_(ga[0][nt][i] + ba), gi = sigmoid_(ga[1][nt][i] + bx);
          const float la = -8.0f * gr * sp;
          const float a = __expf(la);
          av[nt][i] = a;
          uv[nt][i] = sqrtf(fmaxf(1.f - a * a, 0.f)) * (gi * rme);
        }
      }
      __syncthreads();
      float* sAa = (float*)smem;
      float* sU = (float*)(smem + 65536);
#pragma unroll
      for (int nt = 0; nt < 2; ++nt)
#pragma unroll
        for (int i = 0; i < 16; ++i) {
          const int t = crow(i, h), cc = g * 64 + nt * 32 + l32;
          sAa[t * 512 + cc] = av[nt][i];
          sU[t * 512 + cc] = uv[nt][i];
        }
      __syncthreads();
      float hcur = 0.f, pcur = 1.f;
      float hl[32], pl[32];
#pragma unroll
      for (int t = 0; t < 32; ++t) {
        const float a = sAa[t * 512 + c], u = sU[t * 512 + c];
        hcur = a * hcur + u;
        pcur *= a;
        hl[t] = hcur; pl[t] = pcur;
      }
      {
        const unsigned long long bits = ((unsigned long long)__float_as_uint(hcur) << 32) | __float_as_uint(pcur);
        __hip_atomic_store((unsigned long long*)(agg + (size_t)(b * 64 + ft) * 512 + c), bits, __ATOMIC_RELAXED, __HIP_MEMORY_SCOPE_AGENT);
        asm volatile("s_waitcnt vmcnt(0)" ::: "memory");
      }
      __syncthreads();
      if (tid < 64) {
        if (tid == 0) __hip_atomic_store(lflag + b * 64 + ft, 1u, __ATOMIC_RELAXED, __HIP_MEMORY_SCOPE_AGENT);
        if (tid < ft)
          while (__hip_atomic_load(lflag + b * 64 + tid, __ATOMIC_RELAXED, __HIP_MEMORY_SCOPE_AGENT) == 0u) __builtin_amdgcn_s_sleep(1);
      }
      __syncthreads();
      float carry = 0.f;
#pragma unroll 16
      for (int i = 0; i < ft; ++i) {
        const unsigned long long bits = __hip_atomic_load((const unsigned long long*)(agg + (size_t)(b * 64 + i) * 512 + c), __ATOMIC_RELAXED, __HIP_MEMORY_SCOPE_AGENT);
        carry = __uint_as_float((unsigned)bits) * carry + __uint_as_float((unsigned)(bits >> 32));
      }
#pragma unroll
      for (int t = 0; t < 32; ++t) {
        const size_t row = rowbase + t0 + t;
        bf16_t* slot = mix + ((size_t)((512 + c) >> 5) * MT + row) * 32 + (c & 31);
        *slot = f2bf((hl[t] + pl[t] * carry) * bf2f(*slot));
      }
    }
    }
  }
}

DI void phase_lrufix(const Params& p) {
  int c = threadIdx.x;
  asm volatile("" : "+v"(c));
  char* ws = p.ws;
  const bf16_t* gb = (const bf16_t*)(ws + OFF_GB);
  const float* hloc = (const float*)(ws + OFF_HLOC);
  const float* pbuf = (const float*)(ws + OFF_PBUF);
  const float2* agg = (const float2*)(ws + OFF_AGG);
  bf16_t* mix = (bf16_t*)(ws + OFF_MIX);
  for (int item = blockIdx.x; item < 512; item += gridDim.x) {
    const int b = item >> 6, ft = item & 63;
    float carry = 0.f;
#pragma unroll 8
    for (int i = 0; i < ft; ++i) { const float2 a = agg[(size_t)(b * 64 + i) * 512 + c]; carry = a.x * carry + a.y; }
    const size_t row0 = (size_t)b * SEQ + ft * 32;
#pragma unroll 4
    for (int t = 0; t < 32; ++t) {
      const size_t row = row0 + t;
      const float hh = hloc[row * 512 + c] + pbuf[row * 512 + c] * carry;
      const float y = hh * bf2f(gb[row * 512 + c]);
      mix[((size_t)((512 + c) >> 5) * MT + row) * 32 + (c & 31)] = f2bf(y);
    }
  }
}

template <int VAR>
DI void phase_attn(const Params& p, char* smem) {
  int tid = threadIdx.x;
  asm volatile("" : "+v"(tid));
  const int lane = tid & 63, wave = __builtin_amdgcn_readfirstlane(tid >> 6);
  const int l32 = lane & 31, h = lane >> 5;
  char* ws = p.ws;
  const bf16_t* qb = (const bf16_t*)(ws + OFF_Q);
  const bf16_t* kb_ = (const bf16_t*)(ws + OFF_K);
  const bf16_t* vt = (const bf16_t*)(ws + OFF_VT);
  bf16_t* mix = (bf16_t*)(ws + (VAR ? OFF_HLOC : OFF_MIX));
  float d1 = 0.f, d2 = 0.f;
  for (int i = 0; i < 64; ++i) { d1 += p.lq1[i] * p.lk1[i]; d2 += p.lq2[i] * p.lk2[i]; }
  const float lam = expf(d1) - expf(d2) + LAMBDA_INIT;
  constexpr int STAGE = 512 * 64;
  constexpr int QOFF = 3 * STAGE;

  for (int pr = blockIdx.x; pr < 256; pr += gridDim.x) {
    for (int half = 0; half < 2; ++half) {
      int qblk, bh;
      if (gridDim.x == 256) {
        const int qp = pr >> 6;
        qblk = half ? (7 - qp) : qp; bh = ((pr & 7) << 3) | ((pr >> 3) & 7);
      } else {
        const int id = half ? (511 - pr) : pr;
        qblk = id >> 6; bh = id & 63;
      }
      const int q0 = qblk * 256;
      const int T = q0 / 64 + 4;
      const int ntw = (q0 + wave * 32) / 64 + 1;
      const size_t kbase = (size_t)bh * 4 * SEQ * 32;
      const size_t vbase = (size_t)bh * 64 * 128 * 32;

      const int schunk = (tid & 3) ^ ((tid >> 4) & 3);
      const unsigned koff0 = (unsigned)(((tid >> 8) * SEQ + ((tid >> 2) & 63)) * 32 + schunk * 8);
      const unsigned voff0 = (unsigned)((tid >> 2) * 32 + schunk * 8);
      auto issueKV = [&](int t, int stg) __attribute__((always_inline)) {
        char* l = smem + stg * STAGE + tid * 16;
        unsigned k0 = koff0, v0 = voff0;
        asm volatile("" : "+v"(k0), "+v"(v0));
        const bf16_t* gk = kb_ + kbase + (size_t)t * 64 * 32;
        const bf16_t* gv = vt + vbase + (size_t)t * 2 * 128 * 32;
        __builtin_amdgcn_global_load_lds((const unsigned*)(gk + k0), (__attribute__((address_space(3))) unsigned*)(l), 16, 0, 0);
        __builtin_amdgcn_global_load_lds((const unsigned*)(gk + (k0 + 2u * SEQ * 32u)), (__attribute__((address_space(3))) unsigned*)(l + 8192), 16, 0, 0);
        __builtin_amdgcn_global_load_lds((const unsigned*)(gv + v0), (__attribute__((address_space(3))) unsigned*)(l + 16384), 16, 0, 0);
        __builtin_amdgcn_global_load_lds((const unsigned*)(gv + (v0 + 128u * 32u)), (__attribute__((address_space(3))) unsigned*)(l + 24576), 16, 0, 0);
      };

      __syncthreads();
      int tq = tid;
      asm volatile("" : "+v"(tq));
#pragma unroll
      for (int bt = 0; bt < 2; ++bt) {
        u32x4 rq[4];
#pragma unroll
        for (int i = 0; i < 4; ++i) {
          const int q = tq + (bt * 4 + i) * NTHR, row = q >> 2, c = q & 3;
          rq[i] = *(const u32x4*)(qb + kbase + (size_t)q0 * 32 + (unsigned)(((row >> 8) * SEQ + (row & 255)) * 32 + c * 8));
        }
#pragma unroll
        for (int i = 0; i < 4; ++i) {
          const int q = tq + (bt * 4 + i) * NTHR, row = q >> 2, c = q & 3;
          *(u32x4*)(smem + QOFF + lds_off(row, c)) = rq[i];
        }
      }
      issueKV(0, 0); issueKV(1, 1);
      WAITV(4);
      asm volatile("s_waitcnt lgkmcnt(0)" ::: "memory");
      __builtin_amdgcn_s_barrier();
      asm volatile("" ::: "memory");

      float mx[2] = {-1e30f, -1e30f}, ls[2] = {0.f, 0.f};
      f32x16 O[2][4];
#pragma unroll
      for (int m = 0; m < 2; ++m)
#pragma unroll
        for (int mi = 0; mi < 4; ++mi)
#pragma unroll
          for (int i = 0; i < 16; ++i) O[m][mi][i] = 0.f;

      int stg = 0;
      for (int t = 0; t < T; ++t) {
        if (t + 2 < T) issueKV(t + 2, stg == 0 ? 2 : stg - 1);
        const char* base = smem + stg * STAGE;
        if (t < ntw && VAR != 3) {
#pragma unroll
          for (int kb = 0; kb < 2; ++kb) {
            unsigned pk[2][8];
#pragma unroll
            for (int m = 0; m < 2; ++m) {
              f32x16 S;
#pragma unroll
              for (int i = 0; i < 16; ++i) S[i] = 0.f;
              bf16x8 ka[4], qf[4];
#pragma unroll
              for (int ks = 0; ks < 4; ++ks) {
                ka[ks] = *(const bf16x8*)(base + lds_off((m * 2 + (ks >> 1)) * 64 + kb * 32 + l32, (ks & 1) * 2 + h));
                qf[ks] = *(const bf16x8*)(smem + QOFF + lds_off((m * 2 + (ks >> 1)) * 256 + wave * 32 + l32, (ks & 1) * 2 + h));
              }
              __builtin_amdgcn_sched_barrier(0);
#pragma unroll
              for (int ks = 0; ks < 4; ++ks) S = MFMA(ka[ks], qf[ks], S);
              float tm = fmaxf(S[0], S[1]);
#pragma unroll
              for (int i = 2; i < 16; i += 2) tm = fmaxf(fmaxf(tm, S[i]), S[i + 1]);
              tm = half_max(tm);
              const float mn = fmaxf(mx[m], tm);
              if (__builtin_amdgcn_ballot_w64(mn > mx[m]) != 0) {
                const float sc = __builtin_amdgcn_exp2f(mx[m] - mn);
                ls[m] *= sc;
#pragma unroll
                for (int mi = 0; mi < 4; ++mi)
#pragma unroll
                  for (int i = 0; i < 16; ++i) O[m][mi][i] *= sc;
                mx[m] = mn;
              }
              const f32x2_t mn2 = {mx[m], mx[m]};
              f32x2_t accv = {0.f, 0.f};
#pragma unroll
              for (int i = 0; i < 8; ++i) {
                const f32x2_t d = (f32x2_t){S[2 * i], S[2 * i + 1]} - mn2;
                const f32x2_t e = (VAR == 1) ? d : (f32x2_t){__builtin_amdgcn_exp2f(d.x), __builtin_amdgcn_exp2f(d.y)};
                accv += e;
                pk[m][i] = pk2(e.x, e.y);
              }
              ls[m] += accv.x + accv.y;
            }
#pragma unroll
            for (int s = 0; s < 2; ++s) {
              const u32x4 pw0 = {pk[0][4 * s + 0], pk[0][4 * s + 1], pk[0][4 * s + 2], pk[0][4 * s + 3]};
              const u32x4 pw1 = {pk[1][4 * s + 0], pk[1][4 * s + 1], pk[1][4 * s + 2], pk[1][4 * s + 3]};
              const bf16x8 pf0 = __builtin_bit_cast(bf16x8, pw0), pf1 = __builtin_bit_cast(bf16x8, pw1);
              bf16x8 va[4];
#pragma unroll
              for (int mi = 0; mi < 4; ++mi) va[mi] = *(const bf16x8*)(base + lds_off(256 + kb * 128 + mi * 32 + l32, 2 * s + h));
              __builtin_amdgcn_sched_barrier(0);
#pragma unroll
              for (int mi = 0; mi < 4; ++mi) {
                if (VAR != 2) { O[0][mi] = MFMA(va[mi], pf0, O[0][mi]); O[1][mi] = MFMA(va[mi], pf1, O[1][mi]); }
                else { O[0][mi][0] += __builtin_bit_cast(float, pf0[0] + va[mi][0]); O[1][mi][0] += __builtin_bit_cast(float, pf1[1] + va[mi][1]); }
              }
            }
          }
        }
        if (t + 2 < T) WAITV(4); else WAITV(0);
        __builtin_amdgcn_s_barrier();
        asm volatile("" ::: "memory");
        stg = (stg == 2) ? 0 : stg + 1;
      }
      const float l0 = half_sum(ls[0]), l1 = half_sum(ls[1]);
      const float c0 = 1.f / l0, c1 = lam / l1;
      float ssq = 0.f;
#pragma unroll
      for (int mi = 0; mi < 4; ++mi)
#pragma unroll
        for (int i = 0; i < 16; ++i) { const float o = O[0][mi][i] * c0 - O[1][mi][i] * c1; ssq += o * o; }
      ssq = half_sum(ssq);
      const float rs = rsqrtf(ssq * (1.f / 128.f) + LN_EPS) * (1.f - LAMBDA_INIT);
      const int bb = bh >> 3, head = bh & 7;
      const unsigned tok0 = (unsigned)(bb * SEQ + q0 + wave * 32);
      char* wbuf = smem + wave * 8192;
#pragma unroll
      for (int mi = 0; mi < 4; ++mi)
#pragma unroll
        for (int jq = 0; jq < 4; ++jq) {
          const int vd = mi * 32 + 8 * jq + 4 * h;
          const float4 gg = *(const float4*)(p.subln_g + vd);
          const float e0 = O[0][mi][4 * jq + 0] * c0 - O[1][mi][4 * jq + 0] * c1, e1 = O[0][mi][4 * jq + 1] * c0 - O[1][mi][4 * jq + 1] * c1;
          const float e2 = O[0][mi][4 * jq + 2] * c0 - O[1][mi][4 * jq + 2] * c1, e3 = O[0][mi][4 * jq + 3] * c0 - O[1][mi][4 * jq + 3] * c1;
          const unsigned w0 = pk2(e0 * rs * gg.x, e1 * rs * gg.y);
          const unsigned w1 = pk2(e2 * rs * gg.z, e3 * rs * gg.w);
          *(uint2*)(wbuf + mi * 2048 + l32 * 64 + (vd & 31) * 2) = make_uint2(w0, w1);
        }
      __builtin_amdgcn_wave_barrier();
      asm volatile("s_waitcnt lgkmcnt(0)" ::: "memory");
#pragma unroll
      for (int mi = 0; mi < 4; ++mi) {
        char* d = (char*)(mix + (unsigned)(((head * 4 + mi) * MT + tok0) * 32));
#pragma unroll
        for (int e2i = 0; e2i < 2; ++e2i) *(u32x4*)(d + e2i * 1024 + lane * 16) = *(const u32x4*)(wbuf + mi * 2048 + e2i * 1024 + lane * 16);
      }
      __builtin_amdgcn_wave_barrier();
    }
  }
}

template <int PH>
DI void run_phase(const Params& p, char* smem, int dry = 0, int pass = 0) {
  char* ws = p.ws;
  const bf16_t* xb = (const bf16_t*)(ws + OFF_XB);
  const bf16_t* mixb = (const bf16_t*)(ws + OFF_MIX);
  if constexpr (PH == 0) phase_prep(p, smem);
  if constexpr (PH == 1) {
    EpiInProj e{p.b_in, (bf16_t*)(ws + OFF_GLU), (bf16_t*)(ws + OFF_MIX), (bf16_t*)(ws + OFF_RB)};
    gemm_phase<256, 256, 2, 4, 2, false>(xb, MT, (const bf16_t*)(ws + OFF_W_IN), 2048, 1024, smem, e);
  }
  if constexpr (PH == 2) { if (P2_VAR != 0 && pass == 1) phase_convlru<P2_VAR>(p, smem); else phase_convlru<0>(p, smem); }
  if constexpr (PH == 4) {
    EpiLN<false> e{p.out, (bf16_t*)(ws + OFF_XB), p.mix_g, p.mix_b, (float*)(ws + OFF_PART), (unsigned*)(ws + OFF_BAR) + 64, dry, pass};
    gemm_phase<256, 256, 2, 4, 2, false>(mixb, MT, (const bf16_t*)(ws + OFF_W_OUT0), 1024, 1024, smem, e);
  }
  if constexpr (PH == 5) {
    EpiSwiGLU e{(bf16_t*)(ws + OFF_HID)};
    constexpr int NT = 64 * 22, NFULL = (NT / 256) * 256;
    gemm_phase<256, 256, 2, 4, 2, false>(xb, MT, (const bf16_t*)(ws + OFF_W_GU0), 2 * DFF, 1024, smem, e, 0, NFULL);
    gemm_phase<128, 256, 2, 4, 2, false>(xb, MT, (const bf16_t*)(ws + OFF_W_GU0), 2 * DFF, 1024, smem, e, NFULL, NT);
  }
  if constexpr (PH == 6) {
    EpiLN<false> e{p.out, (bf16_t*)(ws + OFF_XB), p.ffn_g, p.ffn_b, (float*)(ws + OFF_PART) + 131072, (unsigned*)(ws + OFF_BAR) + 128, dry, pass};
    gemm_phase<256, 256, 2, 4, 2, false>((const bf16_t*)(ws + OFF_HID), MT, (const bf16_t*)(ws + OFF_W_DN0), 1024, DFF, smem, e);
  }
  if constexpr (PH == 7) {
    EpiQKV e{(bf16_t*)(ws + OFF_Q), (bf16_t*)(ws + OFF_K), (bf16_t*)(ws + OFF_VT), (const float2*)(ws + OFF_ROPE), 0.125f * 1.4426950408889634f};
    gemm_phase<256, 256, 2, 4, 2, false>(xb, MT, (const bf16_t*)(ws + OFF_W_QKV), 3072, 1024, smem, e);
  }
  if constexpr (PH == 8) { if (ATTN_VAR != 0 && pass == 1) phase_attn<ATTN_VAR>(p, smem); else phase_attn<0>(p, smem); }
  if constexpr (PH == 9) {
    EpiLN<false> e{p.out, (bf16_t*)(ws + OFF_XB), p.mix_g + 1024, p.mix_b + 1024, (float*)(ws + OFF_PART) + 2 * 131072, (unsigned*)(ws + OFF_BAR) + 192, dry, pass};
    gemm_phase<256, 256, 2, 4, 2, false>(mixb, MT, (const bf16_t*)(ws + OFF_W_OUT1), 1024, 1024, smem, e);
  }
  if constexpr (PH == 10) {
    EpiSwiGLU e{(bf16_t*)(ws + OFF_HID)};
    constexpr int NT = 64 * 22, NFULL = (NT / 256) * 256;
    gemm_phase<256, 256, 2, 4, 2, false>(xb, MT, (const bf16_t*)(ws + OFF_W_GU1), 2 * DFF, 1024, smem, e, 0, NFULL);
    gemm_phase<128, 256, 2, 4, 2, false>(xb, MT, (const bf16_t*)(ws + OFF_W_GU1), 2 * DFF, 1024, smem, e, NFULL, NT);
  }
  if constexpr (PH == 11) {
    EpiLN<true> e{p.out, (bf16_t*)(ws + OFF_XB), p.ffn_g + 1024, p.ffn_b + 1024, (float*)(ws + OFF_PART) + 3 * 131072, (unsigned*)(ws + OFF_BAR) + 256, dry, pass};
    gemm_phase<256, 256, 2, 4, 2, false>((const bf16_t*)(ws + OFF_HID), MT, (const bf16_t*)(ws + OFF_W_DN1), 1024, DFF, smem, e);
  }
}
#ifndef BAR_NG
#define BAR_NG 64u
#endif
DI void grid_barrier(unsigned* bar, unsigned gen) {
  __syncthreads();
  if (threadIdx.x == 0) {
    const unsigned g = blockIdx.x & (BAR_NG - 1), gsz = gridDim.x / BAR_NG;
    __builtin_amdgcn_fence(__ATOMIC_RELEASE, "agent");
    const unsigned old = __hip_atomic_fetch_add(bar + 2048 + 64 * g, 1u, __ATOMIC_RELAXED, __HIP_MEMORY_SCOPE_AGENT);
    if (old + 1u == gen * gsz) {
      const unsigned old2 = __hip_atomic_fetch_add(bar, 1u, __ATOMIC_RELAXED, __HIP_MEMORY_SCOPE_AGENT);
      if (old2 + 1u == gen * BAR_NG) {
#pragma unroll
        for (int j = 0; j < BAR_NG; ++j) __hip_atomic_store(bar + 6144 + 64 * j, gen, __ATOMIC_RELAXED, __HIP_MEMORY_SCOPE_AGENT);
      }
    }
    while (__hip_atomic_load(bar + 6144 + 64 * g, __ATOMIC_RELAXED, __HIP_MEMORY_SCOPE_AGENT) < gen) __builtin_amdgcn_s_sleep(1);
    __builtin_amdgcn_fence(__ATOMIC_ACQUIRE, "agent");
  }
  __syncthreads();
}
DI void group_barrier(unsigned* ctr, unsigned target) {
  __syncthreads();
  if (threadIdx.x == 0) {
    __builtin_amdgcn_fence(__ATOMIC_RELEASE, "agent");
    __hip_atomic_fetch_add(ctr, 1u, __ATOMIC_RELAXED, __HIP_MEMORY_SCOPE_AGENT);
    while (__hip_atomic_load(ctr, __ATOMIC_RELAXED, __HIP_MEMORY_SCOPE_AGENT) < target) __builtin_amdgcn_s_sleep(1);
    __builtin_amdgcn_fence(__ATOMIC_ACQUIRE, "agent");
  }
  __syncthreads();
}
#ifndef EXTRA_BAR
#define EXTRA_BAR 0
#endif
#ifndef DUP_BAR
#define DUP_BAR 0
#endif
template <int PH, int P1>
DI void run_from(const Params& p, char* smem, unsigned& gen) {
  if constexpr (PH == 0) {
    if (blockIdx.x == 0) { for (int i = threadIdx.x; i < 32768; i += NTHR) __hip_atomic_store((unsigned*)(p.ws + OFF_BAR) + i, 0u, __ATOMIC_RELAXED, __HIP_MEMORY_SCOPE_AGENT); }
  }
  if constexpr ((DUP_MASK >> PH) & 1) { run_phase<PH>(p, smem, 1, 0); if (DUP_BAR) grid_barrier((unsigned*)(p.ws + OFF_BAR) + 4096, ++gen); run_phase<PH>(p, smem, 0, 1); }
  else run_phase<PH>(p, smem);
  if constexpr (PH + 1 < P1) {
    if constexpr (PH == 0) cg::this_grid().sync();
    else if constexpr (PH == 4 || PH == 5 || PH == 9 || PH == 10) {
      if (gridDim.x == 256) {
        constexpr unsigned k = (PH == 4) ? 1u : (PH == 5) ? 2u : (PH == 9) ? 3u : 4u;
        const unsigned grp = (blockIdx.x & 7u) * 8u + ((blockIdx.x >> 3) & 7u);
        group_barrier((unsigned*)(p.ws + OFF_BAR) + 16384 + 64 * grp, 4u * k);
      } else {
        grid_barrier((unsigned*)(p.ws + OFF_BAR) + 4096, ++gen);
      }
    }
    else if constexpr (PH == 1 || PH == 3 || PH == 7) {
      if (gridDim.x == 256) group_barrier((unsigned*)(p.ws + OFF_BAR) + 24576 + 64 * (blockIdx.x & 7u), (PH == 1) ? 32u : (PH == 3) ? 64u : 96u);
      else grid_barrier((unsigned*)(p.ws + OFF_BAR) + 4096, ++gen);
    }
    else if constexpr (PH != 2) grid_barrier((unsigned*)(p.ws + OFF_BAR) + 4096, ++gen);
    if constexpr (PH == 3) { for (int i = 0; i < EXTRA_BAR; ++i) grid_barrier((unsigned*)(p.ws + OFF_BAR) + 4096, ++gen); }
    run_from<PH + 1, P1>(p, smem, gen);
  }
}
template <int P0, int P1>
__global__ void __launch_bounds__(NTHR) fwd_kernel(Params p) {
  __shared__ __attribute__((aligned(16))) char smem[163840];
  unsigned gen = 0;
  run_from<P0, P1>(p, smem, gen);
}

typedef void (*kern_t)(Params);

extern "C" void kernel_launch(void* const* d_in, const int* in_sizes, int n_in, void* d_out, int out_size, void* d_ws, size_t ws_size, hipStream_t stream) {
  static int grid_blocks = 0;
  if (!grid_blocks) {
    int dev = 0, cus = 0, per_cu = 0;
    (void)hipGetDevice(&dev);
    (void)hipDeviceGetAttribute(&cus, hipDeviceAttributeMultiprocessorCount, dev);
#if MK_SINGLE
    (void)hipOccupancyMaxActiveBlocksPerMultiprocessor(&per_cu, fwd_kernel<0, 12>, NTHR, 0);
#else
    per_cu = 1;
#endif
    if (per_cu < 1) per_cu = 1;
    if (cus < 1) cus = 256;
    grid_blocks = (cus * per_cu) & ~63;
  }
  Params p{};
  const float** f = (const float**)&p;
  for (int i = 0; i < 29; ++i) f[i] = (const float*)d_in[i];
  p.out = (float*)d_out; p.ws = (char*)d_ws;
#if MK_SINGLE
  void* args[] = {&p};
  hipError_t e = hipLaunchCooperativeKernel((void*)fwd_kernel<0, 12>, dim3(grid_blocks), dim3(NTHR), args, 0, stream);
  if (e != hipSuccess) fprintf(stderr, "cooperative launch failed: %s (grid %d)\n", hipGetErrorString(e), grid_blocks);
#else
  static const kern_t ks[12] = {fwd_kernel<0, 1>, fwd_kernel<1, 2>, fwd_kernel<2, 3>, fwd_kernel<3, 4>, fwd_kernel<4, 5>, fwd_kernel<5, 6>,
                                fwd_kernel<6, 7>, fwd_kernel<7, 8>, fwd_kernel<8, 9>, fwd_kernel<9, 10>, fwd_kernel<10, 11>, fwd_kernel<11, 12>};
  for (int ph = 0; ph < 12; ++ph) hipLaunchKernelGGL(ks[ph], dim3(grid_blocks), dim3(NTHR), 0, stream, p);
#endif
}
```

```cpp
#include <hip/hip_runtime.h>
#include <hip/hip_cooperative_groups.h>
#include <cstdio>
#include <cstdint>
namespace cg = cooperative_groups;

#ifndef MK_SINGLE
#define MK_SINGLE 1
#endif
#ifndef DUP_MASK
#define DUP_MASK 0
#endif
#ifndef ATTN_VAR
#define ATTN_VAR 0
#endif
#ifndef P2_VAR
#define P2_VAR 0
#endif

typedef unsigned short bf16_t;
typedef short bf16x8 __attribute__((ext_vector_type(8)));
typedef float f32x16 __attribute__((ext_vector_type(16)));
typedef __bf16 bf16x2_t __attribute__((ext_vector_type(2)));
typedef float f32x2_t __attribute__((ext_vector_type(2)));
typedef unsigned u32x4 __attribute__((ext_vector_type(4)));
#define DI __device__ __forceinline__
#define MFMA(a, b, c) __builtin_amdgcn_mfma_f32_32x32x16_bf16((a), (b), (c), 0, 0, 0)

constexpr int MT = 16384;
constexpr int DM = 1024;
constexpr int SEQ = 2048;
constexpr int DFF = 2816;
constexpr int NTHR = 512;
constexpr float LN_EPS = 1e-5f;
constexpr float DN_ALPHA = 1.4142135623730951f;
constexpr float LAMBDA_INIT = 0.35550906759096926f;

constexpr size_t MB = 1024 * 1024;
constexpr size_t OFF_W_IN = 0;
constexpr size_t OFF_W_OUT0 = OFF_W_IN + 4 * MB;
constexpr size_t OFF_W_GU0 = OFF_W_OUT0 + 2 * MB;
constexpr size_t OFF_W_DN0 = OFF_W_GU0 + (size_t)5632 * 1024 * 2;
constexpr size_t OFF_W_QKV = OFF_W_DN0 + (size_t)2816 * 1024 * 2;
constexpr size_t OFF_W_OUT1 = OFF_W_QKV + 6 * MB;
constexpr size_t OFF_W_GU1 = OFF_W_OUT1 + 2 * MB;
constexpr size_t OFF_W_DN1 = OFF_W_GU1 + (size_t)5632 * 1024 * 2;
constexpr size_t OFF_XB = OFF_W_DN1 + (size_t)2816 * 1024 * 2;
constexpr size_t OFF_MIX = OFF_XB + 32 * MB;
constexpr size_t OFF_REGA = OFF_MIX + 32 * MB;
constexpr size_t OFF_GB = OFF_REGA + 16 * MB;
constexpr size_t OFF_HLOC = OFF_REGA + 48 * MB;
constexpr size_t OFF_HID = OFF_REGA;
constexpr size_t OFF_Q = OFF_REGA;
constexpr size_t OFF_K = OFF_REGA + 32 * MB;
constexpr size_t OFF_VT = OFF_REGA + 64 * MB;
constexpr size_t OFF_PBUF = OFF_REGA + 96 * MB;
constexpr size_t OFF_GLU = OFF_PBUF;
constexpr size_t OFF_RB = OFF_PBUF + 16 * MB;
constexpr size_t OFF_AGG = OFF_PBUF + 32 * MB;
constexpr size_t OFF_ROPE = OFF_AGG + 2 * MB;
constexpr size_t OFF_BAR = OFF_ROPE + 1 * MB;
constexpr size_t OFF_PART = OFF_BAR + 1 * MB;
constexpr size_t OFF_WT = OFF_PART + 2 * MB;

struct Params {
  const float* x; const float* w_in; const float* b_in; const float* conv_w; const float* conv_b;
  const float* cn_g; const float* cn_b; const float* lconv_w; const float* lconv_b;
  const float* w_a; const float* b_a; const float* w_x; const float* b_x; const float* lru_lam; const float* w_out0;
  const float* w_qkv; const float* lq1; const float* lk1; const float* lq2; const float* lk2; const float* subln_g; const float* w_out1;
  const float* mix_g; const float* mix_b; const float* ffn_gate; const float* ffn_up; const float* ffn_down;
  const float* ffn_g; const float* ffn_b;
  float* out; char* ws;
};

DI unsigned pk2(float lo, float hi) { f32x2_t v = {lo, hi}; bf16x2_t b = __builtin_convertvector(v, bf16x2_t); return __builtin_bit_cast(unsigned, b); }
DI bf16_t f2bf(float x) { return (bf16_t)(pk2(x, 0.f) & 0xffffu); }
DI float bf2f(bf16_t b) { return __uint_as_float(((unsigned)b) << 16); }
DI int crow(int i, int h) { return (i & 3) + 8 * (i >> 2) + 4 * h; }
DI float sigmoid_(float x) { return __builtin_amdgcn_rcpf(1.f + __expf(-x)); }
DI float silu_(float x) { return x * sigmoid_(x); }
DI float gelu_tanh(float x) {
  float y = 0.7978845608028654f * (x + 0.044715f * x * x * x);
  float t = 1.f - 2.f * __builtin_amdgcn_rcpf(1.f + __expf(2.f * y));
  return 0.5f * x * (1.f + t);
}
DI unsigned lds_off(int row, int chunk) { return (unsigned)(row * 64 + (((chunk ^ (row >> 2)) & 3) << 4)); }
DI float xor_lane(float v, int mask, int lane) { return __int_as_float(__builtin_amdgcn_ds_bpermute((lane ^ mask) << 2, __float_as_int(v))); }
DI float half_max(float v) { auto r = __builtin_amdgcn_permlane32_swap(__float_as_uint(v), __float_as_uint(v), false, false); return fmaxf(__uint_as_float(r[0]), __uint_as_float(r[1])); }
DI float half_sum(float v) { auto r = __builtin_amdgcn_permlane32_swap(__float_as_uint(v), __float_as_uint(v), false, false); return __uint_as_float(r[0]) + __uint_as_float(r[1]); }
template <int CTRL, int ROW_MASK>
DI float dpp_add(float v) {
  return v + __int_as_float(__builtin_amdgcn_update_dpp(0, __float_as_int(v), CTRL, ROW_MASK, 0xf, false));
}
DI float wave_sum(float v, int  ) {
  v = dpp_add<0xB1, 0xf>(v);
  v = dpp_add<0x4E, 0xf>(v);
  v = dpp_add<0x141, 0xf>(v);
  v = dpp_add<0x140, 0xf>(v);
  v = dpp_add<0x142, 0xa>(v);
  v = dpp_add<0x143, 0xc>(v);
  return __int_as_float(__builtin_amdgcn_readlane(__float_as_int(v), 63));
}

DI void cvt_weight(bf16_t* __restrict__ dst, const float* __restrict__ s0, const float* __restrict__ s1,
                   int K, int Nsrc, int Np, int mode, int gtid, int gsz, char* smem) {
  const int total = (K / 32) * Np;
  const int lane = gtid & 63;
  char* wbuf = smem + ((gtid >> 6) & 7) * 4096;
  for (int idx = gtid; idx < total; idx += gsz) {
    const int kg = idx / Np, np = idx - kg * Np;
    const float* src = s0; int n = np;
    if (mode == 1) {
      const int blk = np >> 6, t = np & 63;
      if (blk < 16) n = (t < 32) ? (blk * 32 + t) : (512 + blk * 32 + (t - 32));
      else { const int j = blk - 16; n = (t < 32) ? (1024 + j * 32 + t) : (1536 + j * 32 + (t - 32)); }
    } else if (mode == 2) {
      const int blk = np >> 6, t = np & 63;
      src = (t < 32) ? s0 : s1; n = blk * 32 + (t & 31);
    }
    const float* p = src + (size_t)(kg * 32) * Nsrc + n;
    unsigned o[16];
#pragma unroll
    for (int kk = 0; kk < 16; ++kk) o[kk] = pk2(p[(size_t)(2 * kk) * Nsrc], p[(size_t)(2 * kk + 1) * Nsrc]);
#pragma unroll
    for (int e = 0; e < 4; ++e) *(u32x4*)(wbuf + lane * 64 + e * 16) = (u32x4){o[4 * e], o[4 * e + 1], o[4 * e + 2], o[4 * e + 3]};
    __builtin_amdgcn_wave_barrier();
    asm volatile("s_waitcnt lgkmcnt(0)" ::: "memory");
    char* d = (char*)(dst + (size_t)(idx - lane) * 32);
#pragma unroll
    for (int e = 0; e < 4; ++e) *(u32x4*)(d + e * 1024 + lane * 16) = *(const u32x4*)(wbuf + e * 1024 + lane * 16);
    __builtin_amdgcn_wave_barrier();
  }
}

DI void phase_prep(const Params& p, char* smem) {
  int tid0 = threadIdx.x;
  asm volatile("" : "+v"(tid0));
  const int gtid = blockIdx.x * NTHR + tid0, gsz = gridDim.x * NTHR;
  char* ws = p.ws;
  {
    bf16_t* xb = (bf16_t*)(ws + OFF_XB);
    for (int idx = gtid; idx < MT * 32; idx += gsz) {
      const int kg = idx >> 14, row = idx & (MT - 1);
      const float4* s = (const float4*)(p.x + (size_t)row * DM + kg * 32);
      uint4* d = (uint4*)(xb + ((size_t)kg * MT + row) * 32);
#pragma unroll
      for (int e = 0; e < 4; ++e) {
        float4 a = s[2 * e], b = s[2 * e + 1];
        d[e] = make_uint4(pk2(a.x, a.y), pk2(a.z, a.w), pk2(b.x, b.y), pk2(b.z, b.w));
      }
    }
  }
  cvt_weight((bf16_t*)(ws + OFF_W_IN), p.w_in, p.w_in, 1024, 2048, 2048, 1, gtid, gsz, smem);
  cvt_weight((bf16_t*)(ws + OFF_W_OUT0), p.w_out0, p.w_out0, 1024, 1024, 1024, 0, gtid, gsz, smem);
  cvt_weight((bf16_t*)(ws + OFF_W_GU0), p.ffn_gate, p.ffn_up, 1024, DFF, 2 * DFF, 2, gtid, gsz, smem);
  cvt_weight((bf16_t*)(ws + OFF_W_DN0), p.ffn_down, p.ffn_down, DFF, 1024, 1024, 0, gtid, gsz, smem);
  cvt_weight((bf16_t*)(ws + OFF_W_QKV), p.w_qkv, p.w_qkv, 1024, 3072, 3072, 0, gtid, gsz, smem);
  cvt_weight((bf16_t*)(ws + OFF_W_OUT1), p.w_out1, p.w_out1, 1024, 1024, 1024, 0, gtid, gsz, smem);
  cvt_weight((bf16_t*)(ws + OFF_W_GU1), p.ffn_gate + (size_t)1024 * DFF, p.ffn_up + (size_t)1024 * DFF, 1024, DFF, 2 * DFF, 2, gtid, gsz, smem);
  cvt_weight((bf16_t*)(ws + OFF_W_DN1), p.ffn_down + (size_t)DFF * 1024, p.ffn_down + (size_t)DFF * 1024, DFF, 1024, 1024, 0, gtid, gsz, smem);
  {
    bf16_t* wt = (bf16_t*)(ws + OFF_WT);
    for (int idx = gtid; idx < 2 * 8 * 64 * 8; idx += gsz) {
      const int i8 = idx & 7, j = (idx >> 3) & 63, g = (idx >> 9) & 7, gate = idx >> 12;
      const float* w = (gate ? p.w_x : p.w_a) + (size_t)(g * 64 + i8 * 8) * 64 + j;
      uint4 o = make_uint4(pk2(w[0], w[64]), pk2(w[128], w[192]), pk2(w[256], w[320]), pk2(w[384], w[448]));
      *(uint4*)(wt + (size_t)idx * 8) = o;
    }
  }
  {
    float2* tab = (float2*)(ws + OFF_ROPE);
    for (int idx = gtid; idx < SEQ * 32; idx += gsz) {
      const int pos = idx >> 5, j = idx & 31;
      const float inv = powf(10000.0f, -(float)j / 32.0f);
      const float ang = (float)pos * inv;
      double t = (double)ang * 0.15915494309189535;
      t -= rint(t);
      const float tf = (float)t;
      tab[idx] = make_float2(__builtin_amdgcn_cosf(tf), __builtin_amdgcn_sinf(tf));
    }
  }
}

#define WAITV(n) asm volatile("s_waitcnt vmcnt(" #n ")" ::: "memory")
template <int BM, int BN, int WR, int WC, int G, bool T2MAJOR, class Epi>
DI void gemm_phase(const bf16_t* __restrict__ P1, int R1, const bf16_t* __restrict__ P2, int R2, int K, char* smem, const Epi& epi, int tile_begin = 0, int tile_end = -1) {
  constexpr int MI = BM / WR / 32, NI = BN / WC / 32;
  static_assert((MI == 4 || MI == 2) && NI == 2 && (BM == 256 || BM == 128) && BN == 256, "256 (or 128) x 256 tile, wave tile 128 (or 64) x 64");
  constexpr int SPLIT = 256 / BM;
  constexpr int NDMA = (BM + BN) / 128;
  constexpr int STAGE = (BM + BN) * 64;
  int tid = threadIdx.x;
  asm volatile("" : "+v"(tid));
  const int lane = tid & 63, wave = __builtin_amdgcn_readfirstlane(tid >> 6);
  const int wr = wave / WC, wc = wave % WC;
  const int l32 = lane & 31, h = lane >> 5;
  const int tiles2 = R2 / BN, ntiles = (R1 / 256) * tiles2;
  if (tile_end < 0) tile_end = ntiles;
  const int KT = K / 32;
  const int srow = tid >> 2, schunk = (tid & 3) ^ ((tid >> 4) & 3);
  const unsigned soff = (unsigned)(srow * 32 + schunk * 8);
  const int tiles1 = R1 / 256;
  const bool xcd_order = (gridDim.x == 256) && (tiles1 % 64 == 0);
  const int ppx = tiles1 / 8;
  auto tile_origin = [&](int tile0, int& o1, int& o2) __attribute__((always_inline)) {
    int t1, t2;
    if (xcd_order) {
      const int xcd = tile0 & 7, lt = tile0 >> 3;
      const int grp = lt / (ppx * 4), rem = lt - grp * (ppx * 4);
      t2 = grp * 4 + rem / ppx; t1 = xcd * ppx + rem % ppx;
    } else {
      t1 = T2MAJOR ? (tile0 % tiles1) : (tile0 / tiles2); t2 = T2MAJOR ? (tile0 / tiles1) : (tile0 - t1 * tiles2);
    }
    o1 = t1 * 256; o2 = t2 * BN;
  };
  auto issue = [&](int kt, int o1, int o2) __attribute__((always_inline)) {
    const bf16_t* a1 = P1 + ((size_t)kt * R1 + o1) * 32;
    const bf16_t* a2 = P2 + ((size_t)kt * R2 + o2) * 32;
    char* l = smem + (kt & 3) * STAGE + tid * 16;
#pragma unroll
    for (int i = 0; i < BM / 128; ++i)
      __builtin_amdgcn_global_load_lds((const unsigned*)(a1 + i * 128 * 32 + soff), (__attribute__((address_space(3))) unsigned*)(l + i * 8192), 16, 0, 0);
#pragma unroll
    for (int i = 0; i < BN / 128; ++i)
      __builtin_amdgcn_global_load_lds((const unsigned*)(a2 + i * 128 * 32 + soff), (__attribute__((address_space(3))) unsigned*)(l + BM * 64 + i * 8192), 16, 0, 0);
  };
  bool pref = false;
  for (int u = tile_begin * SPLIT + blockIdx.x; u < tile_end * SPLIT; u += gridDim.x) {
    int o1, o2;
    int ut = u / SPLIT, uh = u % SPLIT;
    if (SPLIT == 2 && xcd_order && (tile_end - tile_begin) * 2 == 256) {
      const int v = u - tile_begin * SPLIT, xcd = v & 7, j = (v >> 3) & 7, m = v >> 6;
      ut = xcd + 8 * ((tile_begin >> 3) + (m >> 1) * 8 + j); uh = m & 1;
    }
    tile_origin(ut, o1, o2);
    o1 += uh * BM;

    f32x16 acc[MI][NI];
#pragma unroll
    for (int mi = 0; mi < MI; ++mi)
#pragma unroll
      for (int ni = 0; ni < NI; ++ni)
#pragma unroll
        for (int i = 0; i < 16; ++i) acc[mi][ni][i] = 0.f;

    if (!pref) {
      __syncthreads();
      issue(0, o1, o2); issue(1, o1, o2); issue(2, o1, o2);
      if constexpr (NDMA == 4) WAITV(8); else WAITV(6);
    } else {
      WAITV(0);
    }
    __builtin_amdgcn_s_barrier();
    if (wr == 1) __builtin_amdgcn_s_barrier();
    __builtin_amdgcn_sched_barrier(0);
    for (int kt = 0; kt < KT; ++kt) {
      const char* base = smem + (kt & 3) * STAGE;
#pragma unroll
      for (int ks = 0; ks < 2; ++ks) {
        const int chunk = ks * 2 + h;
        bf16x8 a[MI], b[NI];
#pragma unroll
        for (int mi = 0; mi < MI; ++mi) a[mi] = *(const bf16x8*)(base + lds_off(wr * (BM / WR) + mi * 32 + l32, chunk));
#pragma unroll
        for (int ni = 0; ni < NI; ++ni) b[ni] = *(const bf16x8*)(base + lds_off(BM + wc * (BN / WC) + ni * 32 + l32, chunk));
        if (ks == 1) {
          if (kt + 3 < KT) { issue(kt + 3, o1, o2); if constexpr (NDMA == 4) WAITV(8); else WAITV(6); }
          else if (kt + 2 < KT) { if constexpr (NDMA == 4) WAITV(4); else WAITV(3); }
          else WAITV(0);
        }
        __builtin_amdgcn_sched_barrier(0);
        __builtin_amdgcn_s_barrier();
        __builtin_amdgcn_sched_barrier(0);
        __builtin_amdgcn_s_setprio(1);
#pragma unroll
        for (int mi = 0; mi < MI; ++mi)
#pragma unroll
          for (int ni = 0; ni < NI; ++ni) acc[mi][ni] = MFMA(a[mi], b[ni], acc[mi][ni]);
        __builtin_amdgcn_s_setprio(0);
        __builtin_amdgcn_sched_barrier(0);
        __builtin_amdgcn_s_barrier();
        __builtin_amdgcn_sched_barrier(0);
      }
    }
    if (wr == 0) __builtin_amdgcn_s_barrier();
    __syncthreads();
    pref = false;
    if (!Epi::kUsesSmem && u + (int)gridDim.x < tile_end * SPLIT) {
      int n1, n2;
      tile_origin((u + (int)gridDim.x) / SPLIT, n1, n2);
      n1 += ((u + (int)gridDim.x) % SPLIT) * BM;
      issue(0, n1, n2); issue(1, n1, n2); issue(2, n1, n2);
      pref = true;
    }
    int lane_e = lane;
    asm volatile("" : "+v"(lane_e));
    epi(acc, o1 + wr * (BM / WR), o2 + wc * (BN / WC), lane_e, smem);
  }
}

struct EpiInProj {
  static constexpr bool kUsesSmem = false;
  const float* b_in; bf16_t* glu; bf16_t* gb; bf16_t* rb;
  DI void operator()(f32x16 (&acc)[4][2], int row0, int col0, int lane, char* smem) const {
    const int l32 = lane & 31, h = lane >> 5;
    const int blk = col0 >> 6;
    const bool isA = blk < 16;
    const int ch = (isA ? blk : blk - 16) * 32 + l32;
    const float b0 = b_in[(isA ? 0 : 1024) + ch], b1 = b_in[(isA ? 512 : 1536) + ch];
    if (isA) {
#pragma unroll
      for (int mi = 0; mi < 4; ++mi)
#pragma unroll
        for (int i = 0; i < 16; ++i) {
          const size_t row = row0 + mi * 32 + crow(i, h);
          const float v0 = acc[mi][0][i] + b0, v1 = acc[mi][1][i] + b1;
          glu[row * 512 + ch] = f2bf(v0 * sigmoid_(v1));
        }
    } else {
      const int wave = (int)__builtin_amdgcn_readfirstlane((int)(threadIdx.x >> 6));
      char* wbuf = smem + 131072 + wave * 4096;
      const size_t kg = (size_t)((512 + (blk - 16) * 32) >> 5);
#pragma unroll
      for (int mp = 0; mp < 2; ++mp) {
#pragma unroll
        for (int mm = 0; mm < 2; ++mm)
#pragma unroll
          for (int i = 0; i < 16; ++i) {
            const int mi = mp * 2 + mm;
            const size_t row = row0 + mi * 32 + crow(i, h);
            const float v0 = acc[mi][0][i] + b0, v1 = acc[mi][1][i] + b1;
            *(bf16_t*)(wbuf + (mm * 32 + crow(i, h)) * 64 + l32 * 2) = f2bf(gelu_tanh(v0));
            rb[row * 512 + ch] = f2bf(v1);
          }
        __builtin_amdgcn_wave_barrier();
        asm volatile("s_waitcnt lgkmcnt(0)" ::: "memory");
        char* d = (char*)(gb + (kg * MT + row0 + mp * 64) * 32);
#pragma unroll
        for (int e = 0; e < 4; ++e) *(u32x4*)(d + e * 1024 + lane * 16) = *(const u32x4*)(wbuf + e * 1024 + lane * 16);
        __builtin_amdgcn_wave_barrier();
      }
    }
  }
};
struct EpiSwiGLU {
  static constexpr bool kUsesSmem = false;
  bf16_t* hid;
  template <int MI>
  DI void operator()(f32x16 (&acc)[MI][2], int row0, int col0, int lane, char* smem) const {
    const int l32 = lane & 31, h = lane >> 5;
    const int wave = (int)__builtin_amdgcn_readfirstlane((int)(threadIdx.x >> 6));
    const size_t kg = col0 >> 6;
    char* wbuf = smem + 131072 + wave * 4096;
#pragma unroll
    for (int mp = 0; mp < MI / 2; ++mp) {
#pragma unroll
      for (int mm = 0; mm < 2; ++mm)
#pragma unroll
        for (int i = 0; i < 16; ++i) {
          const int r = mm * 32 + crow(i, h);
          *(bf16_t*)(wbuf + r * 64 + l32 * 2) = f2bf(silu_(acc[mp * 2 + mm][0][i]) * acc[mp * 2 + mm][1][i]);
        }
      __builtin_amdgcn_wave_barrier();
      asm volatile("s_waitcnt lgkmcnt(0)" ::: "memory");
      char* d = (char*)(hid + (kg * MT + row0 + mp * 64) * 32);
#pragma unroll
      for (int e = 0; e < 4; ++e) *(u32x4*)(d + e * 1024 + lane * 16) = *(const u32x4*)(wbuf + e * 1024 + lane * 16);
      __builtin_amdgcn_wave_barrier();
    }
  }
};
struct EpiQKV {
  static constexpr bool kUsesSmem = false;
  bf16_t* q; bf16_t* k; bf16_t* vt; const float2* rope; float qscale;
  DI void operator()(f32x16 (&acc)[4][2], int row0, int col0, int lane, char* smem) const {
    const int l32 = lane & 31, h = lane >> 5;
    const int wave = (int)__builtin_amdgcn_readfirstlane((int)(threadIdx.x >> 6));
    const int sect = col0 >> 10, within = col0 & 1023, head = within >> 7;
    const int b = row0 >> 11;
    char* wbuf = smem + 131072 + wave * 4096;
    if (sect < 2) {
      const int m = (within >> 6) & 1;
      bf16_t* dst = (sect == 0) ? q : k;
      const float sc = (sect == 0) ? qscale : 1.f;
      const int pos0 = row0 & (SEQ - 1);
#pragma unroll
      for (int mp = 0; mp < 2; ++mp) {
        float olo[2][16], ohi[2][16];
#pragma unroll
        for (int mm = 0; mm < 2; ++mm)
#pragma unroll
          for (int i = 0; i < 16; ++i) {
            const int pos = pos0 + (mp * 2 + mm) * 32 + crow(i, h);
            const float2 cs = rope[pos * 32 + l32];
            const float lo = acc[mp * 2 + mm][0][i], hi = acc[mp * 2 + mm][1][i];
            olo[mm][i] = (lo * cs.x - hi * cs.y) * sc; ohi[mm][i] = (hi * cs.x + lo * cs.y) * sc;
          }
#pragma unroll
        for (int gran = 0; gran < 2; ++gran) {
#pragma unroll
          for (int mm = 0; mm < 2; ++mm)
#pragma unroll
            for (int i = 0; i < 16; ++i)
              *(bf16_t*)(wbuf + (mm * 32 + crow(i, h)) * 64 + l32 * 2) = f2bf(gran ? ohi[mm][i] : olo[mm][i]);
          __builtin_amdgcn_wave_barrier();
          asm volatile("s_waitcnt lgkmcnt(0)" ::: "memory");
          char* d = (char*)(dst + (((size_t)((b * 8 + head) * 2 + m) * 2 + gran) * SEQ + pos0 + mp * 64) * 32);
#pragma unroll
          for (int e = 0; e < 4; ++e) *(u32x4*)(d + e * 1024 + lane * 16) = *(const u32x4*)(wbuf + e * 1024 + lane * 16);
          __builtin_amdgcn_wave_barrier();
        }
      }
    } else {
      const int vd0 = within & 127;
#pragma unroll
      for (int mi = 0; mi < 4; ++mi) {
        const int pos0 = (row0 + mi * 32) & (SEQ - 1);
        const size_t sg = pos0 >> 5;
#pragma unroll
        for (int ni = 0; ni < 2; ++ni)
#pragma unroll
          for (int jq = 0; jq < 4; ++jq) {
            const int ppos = 16 * (jq >> 1) + 8 * h + 4 * (jq & 1);
            const uint2 v = make_uint2(pk2(acc[mi][ni][4 * jq], acc[mi][ni][4 * jq + 1]), pk2(acc[mi][ni][4 * jq + 2], acc[mi][ni][4 * jq + 3]));
            *(uint2*)(wbuf + (ni * 32 + l32) * 64 + ppos * 2) = v;
          }
        __builtin_amdgcn_wave_barrier();
        asm volatile("s_waitcnt lgkmcnt(0)" ::: "memory");
        char* d = (char*)(vt + (((size_t)(b * 8 + head) * 64 + sg) * 128 + vd0) * 32);
#pragma unroll
        for (int e = 0; e < 4; ++e) *(u32x4*)(d + e * 1024 + lane * 16) = *(const u32x4*)(wbuf + e * 1024 + lane * 16);
        __builtin_amdgcn_wave_barrier();
      }
    }
  }
};
template <int X> DI float swz_xor(float v) { return __int_as_float(__builtin_amdgcn_ds_swizzle(__float_as_int(v), 0x1f | (X << 10))); }
DI void reduce_scatter32(float (&v)[32], int l32) {
  { const bool up = (l32 & 16) != 0;
#pragma unroll
    for (int j = 0; j < 16; ++j) { const float keep = up ? v[j + 16] : v[j], send = up ? v[j] : v[j + 16]; v[j] = keep + swz_xor<16>(send); } }
  { const bool up = (l32 & 8) != 0;
#pragma unroll
    for (int j = 0; j < 8; ++j) { const float keep = up ? v[j + 8] : v[j], send = up ? v[j] : v[j + 8]; v[j] = keep + swz_xor<8>(send); } }
  { const bool up = (l32 & 4) != 0;
#pragma unroll
    for (int j = 0; j < 4; ++j) { const float keep = up ? v[j + 4] : v[j], send = up ? v[j] : v[j + 4]; v[j] = keep + swz_xor<4>(send); } }
  { const bool up = (l32 & 2) != 0;
#pragma unroll
    for (int j = 0; j < 2; ++j) { const float keep = up ? v[j + 2] : v[j], send = up ? v[j] : v[j + 2]; v[j] = keep + swz_xor<2>(send); } }
  { const bool up = (l32 & 1) != 0;
    const float keep = up ? v[1] : v[0], send = up ? v[0] : v[1]; v[0] = keep + swz_xor<1>(send); }
}
template <bool FINAL>
struct EpiLN {
  static constexpr bool kUsesSmem = true;
  float* outf; bf16_t* xb; const float* g; const float* bt; float* part; unsigned* flag; int dry; int pass;
  DI void operator()(f32x16 (&acc)[4][2], int row0, int col0, int lane, char* smem) const {
    const int l32 = lane & 31, h = lane >> 5;
    const int wave = (int)__builtin_amdgcn_readfirstlane((int)(threadIdx.x >> 6));
    const int tid_e = wave * 64 + lane;
    const int tb = row0 >> 8, wr = (row0 >> 7) & 1, fb = col0 >> 8, wc = (col0 >> 6) & 3;
    float* T = (float*)smem;
    float2* sred = (float2*)(smem + 131072);
    float2* sstat = (float2*)(smem + 133120);
    const size_t colg = (size_t)fb * 256 + lane * 4;
    bf16_t* xq = xb + ((size_t)(fb * 8 + (lane >> 3)) * MT) * 32 + (lane & 7) * 4;
    float* sgb = (float*)(smem + 135168);
    if (tid_e < 256) { sgb[tid_e] = g[fb * 256 + tid_e]; sgb[256 + tid_e] = bt[fb * 256 + tid_e]; }
#pragma unroll 1
    for (int hh = 0; hh < 2; ++hh) {
      uint2 rres[16];
      {
        const bf16_t* xr = xq + ((size_t)tb * 256 + hh * 128 + wave * 16) * 32;
#pragma unroll
        for (int rr = 0; rr < 16; ++rr) rres[rr] = *(const uint2*)(xr + rr * 32);
      }
      if (wr == hh) {
        float* tw = T + (4 * h) * 256 + wc * 64 + l32;
#pragma unroll
        for (int mi = 0; mi < 4; ++mi)
#pragma unroll
          for (int i = 0; i < 16; ++i) {
            const int rc = mi * 32 + 8 * (i >> 2) + (i & 3);
            tw[rc * 256] = acc[mi][0][i];
            tw[rc * 256 + 32] = acc[mi][1][i];
          }
      }
      __syncthreads();
#pragma unroll
      for (int rr = 0; rr < 16; ++rr) {
        const int rl = wave * 16 + rr;
        const float4 a = *(const float4*)(T + rl * 256 + lane * 4);
        const uint2 rv = rres[rr];
        float4 z;
        z.x = a.x + DN_ALPHA * __uint_as_float(rv.x << 16); z.y = a.y + DN_ALPHA * __uint_as_float(rv.x & 0xffff0000u);
        z.z = a.z + DN_ALPHA * __uint_as_float(rv.y << 16); z.w = a.w + DN_ALPHA * __uint_as_float(rv.y & 0xffff0000u);
        *(float4*)(T + rl * 256 + lane * 4) = z;
        float s = (z.x + z.y) + (z.z + z.w), q = (z.x * z.x + z.y * z.y) + (z.z * z.z + z.w * z.w);
        s = wave_sum(s, lane); q = wave_sum(q, lane);
        if (lane == 0) sred[rl] = make_float2(s, q);
      }
      __syncthreads();
      if (tid_e < 128) {
        const float2 sv = sred[tid_e];
        const unsigned long long bits = ((unsigned long long)__float_as_uint(sv.y) << 32) | __float_as_uint(sv.x);
        __hip_atomic_store((unsigned long long*)(part + ((size_t)(tb * 4 + fb) * 256 + hh * 128 + tid_e) * 2), bits, __ATOMIC_RELAXED, __HIP_MEMORY_SCOPE_AGENT);
        asm volatile("s_waitcnt vmcnt(0)" ::: "memory");
      }
      __syncthreads();
      if (tid_e == 0) {
        __hip_atomic_fetch_add(flag + tb, 1u, __ATOMIC_RELAXED, __HIP_MEMORY_SCOPE_AGENT);
        while (__hip_atomic_load(flag + tb, __ATOMIC_RELAXED, __HIP_MEMORY_SCOPE_AGENT) < 4u * (hh + 1) + 8u * (unsigned)pass) __builtin_amdgcn_s_sleep(1);
      }
      __syncthreads();
      if (tid_e < 128) {
        float a = 0.f, a2 = 0.f;
#pragma unroll
        for (int j = 0; j < 4; ++j) {
          const unsigned long long bits = __hip_atomic_load((const unsigned long long*)(part + ((size_t)(tb * 4 + j) * 256 + hh * 128 + tid_e) * 2), __ATOMIC_RELAXED, __HIP_MEMORY_SCOPE_AGENT);
          a += __uint_as_float((unsigned)bits); a2 += __uint_as_float((unsigned)(bits >> 32));
        }
        const float mean = a * (1.f / 1024.f);
        const float var = fmaxf(a2 * (1.f / 1024.f) - mean * mean, 0.f);
        sstat[tid_e] = make_float2(mean, rsqrtf(var + LN_EPS));
      }
      __syncthreads();
      if (FINAL) {
        const float4 gg = *(const float4*)(g + colg), bb = *(const float4*)(bt + colg);
#pragma unroll 1
        for (int rr = 0; rr < 16; ++rr) {
          const int rl = wave * 16 + rr;
          const size_t row = (size_t)tb * 256 + hh * 128 + rl;
          const float2 st = sstat[rl];
          const float4 z = *(const float4*)(T + rl * 256 + lane * 4);
          float4 o;
          o.x = (z.x - st.x) * st.y * gg.x + bb.x; o.y = (z.y - st.x) * st.y * gg.y + bb.y;
          o.z = (z.z - st.x) * st.y * gg.z + bb.z; o.w = (z.w - st.x) * st.y * gg.w + bb.w;
          *(float4*)(outf + row * DM + colg) = o;
        }
      } else if (!dry) {
        const int r = lane >> 2, pc = lane & 3, rl = wave * 16 + r;
        const float2 st = sstat[rl];
        const size_t row = (size_t)tb * 256 + hh * 128 + rl;
#pragma unroll 2
        for (int gq = 0; gq < 8; ++gq) {
          const int c0 = gq * 32 + pc * 8;
          const float4 z0 = *(const float4*)(T + rl * 256 + c0), z1 = *(const float4*)(T + rl * 256 + c0 + 4);
          const float4 g0 = *(const float4*)(sgb + c0), g1 = *(const float4*)(sgb + c0 + 4);
          const float4 b0 = *(const float4*)(sgb + 256 + c0), b1 = *(const float4*)(sgb + 256 + c0 + 4);
          const u32x4 o = {pk2((z0.x - st.x) * st.y * g0.x + b0.x, (z0.y - st.x) * st.y * g0.y + b0.y),
                           pk2((z0.z - st.x) * st.y * g0.z + b0.z, (z0.w - st.x) * st.y * g0.w + b0.w),
                           pk2((z1.x - st.x) * st.y * g1.x + b1.x, (z1.y - st.x) * st.y * g1.y + b1.y),
                           pk2((z1.z - st.x) * st.y * g1.z + b1.z, (z1.w - st.x) * st.y * g1.w + b1.w)};
          *(u32x4*)(xb + ((size_t)(fb * 8 + gq) * MT + row) * 32 + pc * 8) = o;
        }
      }
      __syncthreads();
    }
  }
};

template <int VAR>
DI void phase_convlru(const Params& p, char* smem) {
  int tid = threadIdx.x;
  asm volatile("" : "+v"(tid));
  const int lane = tid & 63, wave = tid >> 6;
  const int c = tid;
  char* ws = p.ws;
  const bf16_t* glu = (const bf16_t*)(ws + OFF_GLU);
  const bf16_t* rbuf = (const bf16_t*)(ws + OFF_RB);
  const bf16_t* gbuf = (const bf16_t*)(ws + OFF_GB);
  float2* agg = (float2*)(ws + OFF_AGG);
  unsigned* lflag = (unsigned*)(ws + OFF_BAR) + 512;
  bf16_t* mix = (bf16_t*)(ws + (VAR ? OFF_HLOC : OFF_MIX));
  bf16_t* sA = (bf16_t*)smem;
  float* sOut = (float*)(smem + 63488);
  bf16_t* sR = (bf16_t*)smem;
  constexpr int RS = 516;
  float* sRf = (float*)(smem + 36864);

  const bool own_batch = (gridDim.x == 256);
  for (int it = blockIdx.x; it < 512; it += gridDim.x) {
    const int item = own_batch ? (((it & 7) << 6) | ((it >> 3) & 31) | ((it >> 8) << 5)) : it;
    const int b = item >> 6, ft = item & 63, t0 = ft * 32;
    const size_t rowbase = (size_t)b * SEQ;
    __syncthreads();
    if (VAR != 1) {
    for (int q = tid; q < 62 * 64; q += NTHR) {
      const int r = q >> 6, cc = q & 63, fr = t0 - 30 + r;
      uint4 v = make_uint4(0, 0, 0, 0);
      if (fr >= 0) v = *(const uint4*)(glu + (rowbase + fr) * 512 + cc * 8);
      *(uint4*)(sA + r * 512 + cc * 8) = v;
    }
    __syncthreads();
    {
      int cq = c;
      asm volatile("" : "+v"(cq));
      float cw[31];
#pragma unroll
      for (int j = 0; j < 31; ++j) cw[j] = p.conv_w[j * 512 + cq];
      const float cb = p.conv_b[cq];
      float xin[62];
#pragma unroll
      for (int r = 0; r < 62; ++r) xin[r] = bf2f(sA[r * 512 + c]);
#pragma unroll
      for (int t = 0; t < 32; ++t) {
        float a = cb;
#pragma unroll
        for (int j = 0; j < 31; ++j) a += cw[j] * xin[t + j];
        sOut[t * 512 + c] = a;
      }
    }
    __syncthreads();
    for (int t = wave; t < 32; t += 8) {
      float v[8]; float s = 0.f;
#pragma unroll
      for (int e = 0; e < 8; ++e) { v[e] = sOut[t * 512 + e * 64 + lane]; s += v[e]; }
      s = wave_sum(s, lane);
      const float mean = s * (1.f / 512.f);
      float s2 = 0.f;
#pragma unroll
      for (int e = 0; e < 8; ++e) { const float d = v[e] - mean; s2 += d * d; }
      s2 = wave_sum(s2, lane);
      const float rstd = rsqrtf(s2 * (1.f / 512.f) + LN_EPS);
      const size_t row = rowbase + t0 + t;
#pragma unroll
      for (int e = 0; e < 8; ++e) {
        const int ch = e * 64 + lane;
        const float y = (v[e] - mean) * rstd * p.cn_g[ch] + p.cn_b[ch];
        mix[((size_t)(ch >> 5) * MT + row) * 32 + (ch & 31)] = f2bf(silu_(y));
      }
    }
    __syncthreads();
    }
    if (VAR != 2) {
    for (int q = tid; q < 35 * 64; q += NTHR) {
      const int r = q >> 6, cc = q & 63, fr = t0 - 3 + r;
      uint4 v = make_uint4(0, 0, 0, 0);
      if (fr >= 0) v = *(const uint4*)(rbuf + (rowbase + fr) * 512 + cc * 8);
      *(uint4*)(sR + r * 512 + cc * 8) = v;
    }
    __syncthreads();
    {
      const float w0 = p.lconv_w[c], w1 = p.lconv_w[512 + c], w2 = p.lconv_w[1024 + c], w3 = p.lconv_w[1536 + c];
      const float lb = p.lconv_b[c];
      for (int t = 0; t < 32; ++t) {
        float a = lb;
        a += w0 * bf2f(sR[(t + 0) * 512 + c]);
        a += w1 * bf2f(sR[(t + 1) * 512 + c]);
        a += w2 * bf2f(sR[(t + 2) * 512 + c]);
        a += w3 * bf2f(sR[(t + 3) * 512 + c]);
        sRf[t * RS + c] = a;
      }
    }
    __syncthreads();
    {
      const int g = wave, l32 = lane & 31, h = lane >> 5;
      const bf16_t* wt = (const bf16_t*)(ws + OFF_WT);
      bf16x8 af[4];
#pragma unroll
      for (int ks = 0; ks < 4; ++ks) {
        const float4 lo = *(const float4*)(sRf + l32 * RS + g * 64 + ks * 16 + 8 * h);
        const float4 hi = *(const float4*)(sRf + l32 * RS + g * 64 + ks * 16 + 8 * h + 4);
        const u32x4 pw = {pk2(lo.x, lo.y), pk2(lo.z, lo.w), pk2(hi.x, hi.y), pk2(hi.z, hi.w)};
        af[ks] = __builtin_bit_cast(bf16x8, pw);
      }
      f32x16 ga[2][2];
#pragma unroll
      for (int gate = 0; gate < 2; ++gate)
#pragma unroll
        for (int nt = 0; nt < 2; ++nt) {
#pragma unroll
          for (int i = 0; i < 16; ++i) ga[gate][nt][i] = 0.f;
#pragma unroll
          for (int ks = 0; ks < 4; ++ks) {
            const bf16x8 bfrag = *(const bf16x8*)(wt + ((size_t)((gate * 8 + g) * 64 + nt * 32 + l32)) * 64 + ks * 16 + 8 * h);
            ga[gate][nt] = MFMA(af[ks], bfrag, ga[gate][nt]);
          }
        }
      float av[2][16], uv[2][16];
#pragma unroll
      for (int nt = 0; nt < 2; ++nt) {
        const int cc = g * 64 + nt * 32 + l32;
        const float ba = p.b_a[cc], bx = p.b_x[cc];
        const float sp = log1pf(__expf(-p.lru_lam[cc]));
#pragma unroll
        for (int i = 0; i < 16; ++i) {
          const int t = crow(i, h);
          const float rme = sRf[t * RS + cc];
          const float gr = sigmoid_(ga[0][nt][i] + ba), gi = sigmoid_(ga[1][nt][i] + bx);
          const float la = -8.0f * gr * sp;
          const float a = __expf(la);
          av[nt][i] = a;
          uv[nt][i] = sqrtf(fmaxf(1.f - a * a, 0.f)) * (gi * rme);
        }
      }
      __syncthreads();
      float* sAa = (float*)smem;
      float* sU = (float*)(smem + 65536);
#pragma unroll
      for (int nt = 0; nt < 2; ++nt)
#pragma unroll
        for (int i = 0; i < 16; ++i) {
          const int t = crow(i, h), cc = g * 64 + nt * 32 + l32;
          sAa[t * 512 + cc] = av[nt][i];
          sU[t * 512 + cc] = uv[nt][i];
        }
      __syncthreads();
      float hcur = 0.f, pcur = 1.f;
      float hl[32], pl[32];
#pragma unroll
      for (int t = 0; t < 32; ++t) {
        const float a = sAa[t * 512 + c], u = sU[t * 512 + c];
        hcur = a * hcur + u;
        pcur *= a;
        hl[t] = hcur; pl[t] = pcur;
      }
      {
        const unsigned long long bits = ((unsigned long long)__float_as_uint(hcur) << 32) | __float_as_uint(pcur);
        __hip_atomic_store((unsigned long long*)(agg + (size_t)(b * 64 + ft) * 512 + c), bits, __ATOMIC_RELAXED, __HIP_MEMORY_SCOPE_AGENT);
        asm volatile("s_waitcnt vmcnt(0)" ::: "memory");
      }
      __syncthreads();
      if (tid < 64) {
        if (tid == 0) __hip_atomic_store(lflag + b * 64 + ft, 1u, __ATOMIC_RELAXED, __HIP_MEMORY_SCOPE_AGENT);
        if (tid < ft)
          while (__hip_atomic_load(lflag + b * 64 + tid, __ATOMIC_RELAXED, __HIP_MEMORY_SCOPE_AGENT) == 0u) __builtin_amdgcn_s_sleep(1);
      }
      __syncthreads();
      float carry = 0.f;
#pragma unroll 16
      for (int i = 0; i < ft; ++i) {
        const unsigned long long bits = __hip_atomic_load((const unsigned long long*)(agg + (size_t)(b * 64 + i) * 512 + c), __ATOMIC_RELAXED, __HIP_MEMORY_SCOPE_AGENT);
        carry = __uint_as_float((unsigned)bits) * carry + __uint_as_float((unsigned)(bits >> 32));
      }
#pragma unroll
      for (int t = 0; t < 32; ++t) {
        const size_t row = rowbase + t0 + t;
        bf16_t* slot = mix + ((size_t)((512 + c) >> 5) * MT + row) * 32 + (c & 31);
        *slot = f2bf((hl[t] + pl[t] * carry) * bf2f(*slot));
      }
    }
    }
  }
}

DI void phase_lrufix(const Params& p) {
  int c = threadIdx.x;
  asm volatile("" : "+v"(c));
  char* ws = p.ws;
  const bf16_t* gb = (const bf16_t*)(ws + OFF_GB);
  const float* hloc = (const float*)(ws + OFF_HLOC);
  const float* pbuf = (const float*)(ws + OFF_PBUF);
  const float2* agg = (const float2*)(ws + OFF_AGG);
  bf16_t* mix = (bf16_t*)(ws + OFF_MIX);
  for (int item = blockIdx.x; item < 512; item += gridDim.x) {
    const int b = item >> 6, ft = item & 63;
    float carry = 0.f;
#pragma unroll 8
    for (int i = 0; i < ft; ++i) { const float2 a = agg[(size_t)(b * 64 + i) * 512 + c]; carry = a.x * carry + a.y; }
    const size_t row0 = (size_t)b * SEQ + ft * 32;
#pragma unroll 4
    for (int t = 0; t < 32; ++t) {
      const size_t row = row0 + t;
      const float hh = hloc[row * 512 + c] + pbuf[row * 512 + c] * carry;
      const float y = hh * bf2f(gb[row * 512 + c]);
      mix[((size_t)((512 + c) >> 5) * MT + row) * 32 + (c & 31)] = f2bf(y);
    }
  }
}

template <int VAR>
DI void phase_attn(const Params& p, char* smem) {
  int tid = threadIdx.x;
  asm volatile("" : "+v"(tid));
  const int lane = tid & 63, wave = __builtin_amdgcn_readfirstlane(tid >> 6);
  const int l32 = lane & 31, h = lane >> 5;
  char* ws = p.ws;
  const bf16_t* qb = (const bf16_t*)(ws + OFF_Q);
  const bf16_t* kb_ = (const bf16_t*)(ws + OFF_K);
  const bf16_t* vt = (const bf16_t*)(ws + OFF_VT);
  bf16_t* mix = (bf16_t*)(ws + (VAR ? OFF_HLOC : OFF_MIX));
  float d1 = 0.f, d2 = 0.f;
  for (int i = 0; i < 64; ++i) { d1 += p.lq1[i] * p.lk1[i]; d2 += p.lq2[i] * p.lk2[i]; }
  const float lam = expf(d1) - expf(d2) + LAMBDA_INIT;
  constexpr int STAGE = 512 * 64;
  constexpr int QOFF = 3 * STAGE;

  for (int pr = blockIdx.x; pr < 256; pr += gridDim.x) {
    for (int half = 0; half < 2; ++half) {
      int qblk, bh;
      if (gridDim.x == 256) {
        const int qp = pr >> 6;
        qblk = half ? (7 - qp) : qp; bh = ((pr & 7) << 3) | ((pr >> 3) & 7);
      } else {
        const int id = half ? (511 - pr) : pr;
        qblk = id >> 6; bh = id & 63;
      }
      const int q0 = qblk * 256;
      const int T = q0 / 64 + 4;
      const int ntw = (q0 + wave * 32) / 64 + 1;
      const size_t kbase = (size_t)bh * 4 * SEQ * 32;
      const size_t vbase = (size_t)bh * 64 * 128 * 32;

      const int schunk = (tid & 3) ^ ((tid >> 4) & 3);
      const unsigned koff0 = (unsigned)(((tid >> 8) * SEQ + ((tid >> 2) & 63)) * 32 + schunk * 8);
      const unsigned voff0 = (unsigned)((tid >> 2) * 32 + schunk * 8);
      auto issueKV = [&](int t, int stg) __attribute__((always_inline)) {
        char* l = smem + stg * STAGE + tid * 16;
        unsigned k0 = koff0, v0 = voff0;
        asm volatile("" : "+v"(k0), "+v"(v0));
        const bf16_t* gk = kb_ + kbase + (size_t)t * 64 * 32;
        const bf16_t* gv = vt + vbase + (size_t)t * 2 * 128 * 32;
        __builtin_amdgcn_global_load_lds((const unsigned*)(gk + k0), (__attribute__((address_space(3))) unsigned*)(l), 16, 0, 0);
        __builtin_amdgcn_global_load_lds((const unsigned*)(gk + (k0 + 2u * SEQ * 32u)), (__attribute__((address_space(3))) unsigned*)(l + 8192), 16, 0, 0);
        __builtin_amdgcn_global_load_lds((const unsigned*)(gv + v0), (__attribute__((address_space(3))) unsigned*)(l + 16384), 16, 0, 0);
        __builtin_amdgcn_global_load_lds((const unsigned*)(gv + (v0 + 128u * 32u)), (__attribute__((address_space(3))) unsigned*)(l + 24576), 16, 0, 0);
      };

      __syncthreads();
      int tq = tid;
      asm volatile("" : "+v"(tq));
#pragma unroll
      for (int bt = 0; bt < 2; ++bt) {
        u32x4 rq[4];
#pragma unroll
        for (int i = 0; i < 4; ++i) {
          const int q = tq + (bt * 4 + i) * NTHR, row = q >> 2, c = q & 3;
          rq[i] = *(const u32x4*)(qb + kbase + (size_t)q0 * 32 + (unsigned)(((row >> 8) * SEQ + (row & 255)) * 32 + c * 8));
        }
#pragma unroll
        for (int i = 0; i < 4; ++i) {
          const int q = tq + (bt * 4 + i) * NTHR, row = q >> 2, c = q & 3;
          *(u32x4*)(smem + QOFF + lds_off(row, c)) = rq[i];
        }
      }
      issueKV(0, 0); issueKV(1, 1);
      WAITV(4);
      asm volatile("s_waitcnt lgkmcnt(0)" ::: "memory");
      __builtin_amdgcn_s_barrier();
      asm volatile("" ::: "memory");

      float mx[2] = {-1e30f, -1e30f}, ls[2] = {0.f, 0.f};
      f32x16 O[2][4];
#pragma unroll
      for (int m = 0; m < 2; ++m)
#pragma unroll
        for (int mi = 0; mi < 4; ++mi)
#pragma unroll
          for (int i = 0; i < 16; ++i) O[m][mi][i] = 0.f;

      int stg = 0;
      for (int t = 0; t < T; ++t) {
        if (t + 2 < T) issueKV(t + 2, stg == 0 ? 2 : stg - 1);
        const char* base = smem + stg * STAGE;
        if (t < ntw && VAR != 3) {
#pragma unroll
          for (int kb = 0; kb < 2; ++kb) {
            unsigned pk[2][8];
#pragma unroll
            for (int m = 0; m < 2; ++m) {
              f32x16 S;
#pragma unroll
              for (int i = 0; i < 16; ++i) S[i] = 0.f;
              bf16x8 ka[4], qf[4];
#pragma unroll
              for (int ks = 0; ks < 4; ++ks) {
                ka[ks] = *(const bf16x8*)(base + lds_off((m * 2 + (ks >> 1)) * 64 + kb * 32 + l32, (ks & 1) * 2 + h));
                qf[ks] = *(const bf16x8*)(smem + QOFF + lds_off((m * 2 + (ks >> 1)) * 256 + wave * 32 + l32, (ks & 1) * 2 + h));
              }
              __builtin_amdgcn_sched_barrier(0);
#pragma unroll
              for (int ks = 0; ks < 4; ++ks) S = MFMA(ka[ks], qf[ks], S);
              float tm = fmaxf(S[0], S[1]);
#pragma unroll
              for (int i = 2; i < 16; i += 2) tm = fmaxf(fmaxf(tm, S[i]), S[i + 1]);
              tm = half_max(tm);
              const float mn = fmaxf(mx[m], tm);
              if (__builtin_amdgcn_ballot_w64(mn > mx[m]) != 0) {
                const float sc = __builtin_amdgcn_exp2f(mx[m] - mn);
                ls[m] *= sc;
#pragma unroll
                for (int mi = 0; mi < 4; ++mi)
#pragma unroll
                  for (int i = 0; i < 16; ++i) O[m][mi][i] *= sc;
                mx[m] = mn;
              }
              const f32x2_t mn2 = {mx[m], mx[m]};
              f32x2_t accv = {0.f, 0.f};
#pragma unroll
              for (int i = 0; i < 8; ++i) {
                const f32x2_t d = (f32x2_t){S[2 * i], S[2 * i + 1]} - mn2;
                const f32x2_t e = (VAR == 1) ? d : (f32x2_t){__builtin_amdgcn_exp2f(d.x), __builtin_amdgcn_exp2f(d.y)};
                accv += e;
                pk[m][i] = pk2(e.x, e.y);
              }
              ls[m] += accv.x + accv.y;
            }
#pragma unroll
            for (int s = 0; s < 2; ++s) {
              const u32x4 pw0 = {pk[0][4 * s + 0], pk[0][4 * s + 1], pk[0][4 * s + 2], pk[0][4 * s + 3]};
              const u32x4 pw1 = {pk[1][4 * s + 0], pk[1][4 * s + 1], pk[1][4 * s + 2], pk[1][4 * s + 3]};
              const bf16x8 pf0 = __builtin_bit_cast(bf16x8, pw0), pf1 = __builtin_bit_cast(bf16x8, pw1);
              bf16x8 va[4];
#pragma unroll
              for (int mi = 0; mi < 4; ++mi) va[mi] = *(const bf16x8*)(base + lds_off(256 + kb * 128 + mi * 32 + l32, 2 * s + h));
              __builtin_amdgcn_sched_barrier(0);
#pragma unroll
              for (int mi = 0; mi < 4; ++mi) {
                if (VAR != 2) { O[0][mi] = MFMA(va[mi], pf0, O[0][mi]); O[1][mi] = MFMA(va[mi], pf1, O[1][mi]); }
                else { O[0][mi][0] += __builtin_bit_cast(float, pf0[0] + va[mi][0]); O[1][mi][0] += __builtin_bit_cast(float, pf1[1] + va[mi][1]); }
              }
            }
          }
        }
        if (t + 2 < T) WAITV(4); else WAITV(0);
        __builtin_amdgcn_s_barrier();
        asm volatile("" ::: "memory");
        stg = (stg == 2) ? 0 : stg + 1;
      }
      const float l0 = half_sum(ls[0]), l1 = half_sum(ls[1]);
      const float c0 = 1.f / l0, c1 = lam / l1;
      float ssq = 0.f;
#pragma unroll
      for (int mi = 0; mi < 4; ++mi)
#pragma unroll
        for (int i = 0; i < 16; ++i) { const float o = O[0][mi][i] * c0 - O[1][mi][i] * c1; ssq += o * o; }
      ssq = half_sum(ssq);
      const float rs = rsqrtf(ssq * (1.f / 128.f) + LN_EPS) * (1.f - LAMBDA_INIT);
      const int bb = bh >> 3, head = bh & 7;
      const unsigned tok0 = (unsigned)(bb * SEQ + q0 + wave * 32);
      char* wbuf = smem + wave * 8192;
#pragma unroll
      for (int mi = 0; mi < 4; ++mi)
#pragma unroll
        for (int jq = 0; jq < 4; ++jq) {
          const int vd = mi * 32 + 8 * jq + 4 * h;
          const float4 gg = *(const float4*)(p.subln_g + vd);
          const float e0 = O[0][mi][4 * jq + 0] * c0 - O[1][mi][4 * jq + 0] * c1, e1 = O[0][mi][4 * jq + 1] * c0 - O[1][mi][4 * jq + 1] * c1;
          const float e2 = O[0][mi][4 * jq + 2] * c0 - O[1][mi][4 * jq + 2] * c1, e3 = O[0][mi][4 * jq + 3] * c0 - O[1][mi][4 * jq + 3] * c1;
          const unsigned w0 = pk2(e0 * rs * gg.x, e1 * rs * gg.y);
          const unsigned w1 = pk2(e2 * rs * gg.z, e3 * rs * gg.w);
          *(uint2*)(wbuf + mi * 2048 + l32 * 64 + (vd & 31) * 2) = make_uint2(w0, w1);
        }
      __builtin_amdgcn_wave_barrier();
      asm volatile("s_waitcnt lgkmcnt(0)" ::: "memory");
#pragma unroll
      for (int mi = 0; mi < 4; ++mi) {
        char* d = (char*)(mix + (unsigned)(((head * 4 + mi) * MT + tok0) * 32));
#pragma unroll
        for (int e2i = 0; e2i < 2; ++e2i) *(u32x4*)(d + e2i * 1024 + lane * 16) = *(const u32x4*)(wbuf + mi * 2048 + e2i * 1024 + lane * 16);
      }
      __builtin_amdgcn_wave_barrier();
    }
  }
}

template <int PH>
DI void run_phase(const Params& p, char* smem, int dry = 0, int pass = 0) {
  char* ws = p.ws;
  const bf16_t* xb = (const bf16_t*)(ws + OFF_XB);
  const bf16_t* mixb = (const bf16_t*)(ws + OFF_MIX);
  if constexpr (PH == 0) phase_prep(p, smem);
  if constexpr (PH == 1) {
    EpiInProj e{p.b_in, (bf16_t*)(ws + OFF_GLU), (bf16_t*)(ws + OFF_MIX), (bf16_t*)(ws + OFF_RB)};
    gemm_phase<256, 256, 2, 4, 2, false>(xb, MT, (const bf16_t*)(ws + OFF_W_IN), 2048, 1024, smem, e);
  }
  if constexpr (PH == 2) { if (P2_VAR != 0 && pass == 1) phase_convlru<P2_VAR>(p, smem); else phase_convlru<0>(p, smem); }
  if constexpr (PH == 4) {
    EpiLN<false> e{p.out, (bf16_t*)(ws + OFF_XB), p.mix_g, p.mix_b, (float*)(ws + OFF_PART), (unsigned*)(ws + OFF_BAR) + 64, dry, pass};
    gemm_phase<256, 256, 2, 4, 2, false>(mixb, MT, (const bf16_t*)(ws + OFF_W_OUT0), 1024, 1024, smem, e);
  }
  if constexpr (PH == 5) {
    EpiSwiGLU e{(bf16_t*)(ws + OFF_HID)};
    constexpr int NT = 64 * 22, NFULL = (NT / 256) * 256;
    gemm_phase<256, 256, 2, 4, 2, false>(xb, MT, (const bf16_t*)(ws + OFF_W_GU0), 2 * DFF, 1024, smem, e, 0, NFULL);
    gemm_phase<128, 256, 2, 4, 2, false>(xb, MT, (const bf16_t*)(ws + OFF_W_GU0), 2 * DFF, 1024, smem, e, NFULL, NT);
  }
  if constexpr (PH == 6) {
    EpiLN<false> e{p.out, (bf16_t*)(ws + OFF_XB), p.ffn_g, p.ffn_b, (float*)(ws + OFF_PART) + 131072, (unsigned*)(ws + OFF_BAR) + 128, dry, pass};
    gemm_phase<256, 256, 2, 4, 2, false>((const bf16_t*)(ws + OFF_HID), MT, (const bf16_t*)(ws + OFF_W_DN0), 1024, DFF, smem, e);
  }
  if constexpr (PH == 7) {
    EpiQKV e{(bf16_t*)(ws + OFF_Q), (bf16_t*)(ws + OFF_K), (bf16_t*)(ws + OFF_VT), (const float2*)(ws + OFF_ROPE), 0.125f * 1.4426950408889634f};
    gemm_phase<256, 256, 2, 4, 2, false>(xb, MT, (const bf16_t*)(ws + OFF_W_QKV), 3072, 1024, smem, e);
  }
  if constexpr (PH == 8) { if (ATTN_VAR != 0 && pass == 1) phase_attn<ATTN_VAR>(p, smem); else phase_attn<0>(p, smem); }
  if constexpr (PH == 9) {
    EpiLN<false> e{p.out, (bf16_t*)(ws + OFF_XB), p.mix_g + 1024, p.mix_b + 1024, (float*)(ws + OFF_PART) + 2 * 131072, (unsigned*)(ws + OFF_BAR) + 192, dry, pass};
    gemm_phase<256, 256, 2, 4, 2, false>(mixb, MT, (const bf16_t*)(ws + OFF_W_OUT1), 1024, 1024, smem, e);
  }
  if constexpr (PH == 10) {
    EpiSwiGLU e{(bf16_t*)(ws + OFF_HID)};
    constexpr int NT = 64 * 22, NFULL = (NT / 256) * 256;
    gemm_phase<256, 256, 2, 4, 2, false>(xb, MT, (const bf16_t*)(ws + OFF_W_GU1), 2 * DFF, 1024, smem, e, 0, NFULL);
    gemm_phase<128, 256, 2, 4, 2, false>(xb, MT, (const bf16_t*)(ws + OFF_W_GU1), 2 * DFF, 1024, smem, e, NFULL, NT);
  }
  if constexpr (PH == 11) {
    EpiLN<true> e{p.out, (bf16_t*)(ws + OFF_XB), p.ffn_g + 1024, p.ffn_b + 1024, (float*)(ws + OFF_PART) + 3 * 131072, (unsigned*)(ws + OFF_BAR) + 256, dry, pass};
    gemm_phase<256, 256, 2, 4, 2, false>((const bf16_t*)(ws + OFF_HID), MT, (const bf16_t*)(ws + OFF_W_DN1), 1024, DFF, smem, e);
  }
}
#ifndef BAR_NG
#define BAR_NG 64u
#endif
DI void grid_barrier(unsigned* bar, unsigned gen) {
  __syncthreads();
  if (threadIdx.x == 0) {
    const unsigned g = blockIdx.x & (BAR_NG - 1), gsz = gridDim.x / BAR_NG;
    __builtin_amdgcn_fence(__ATOMIC_RELEASE, "agent");
    const unsigned old = __hip_atomic_fetch_add(bar + 2048 + 64 * g, 1u, __ATOMIC_RELAXED, __HIP_MEMORY_SCOPE_AGENT);
    if (old + 1u == gen * gsz) {
      const unsigned old2 = __hip_atomic_fetch_add(bar, 1u, __ATOMIC_RELAXED, __HIP_MEMORY_SCOPE_AGENT);
      if (old2 + 1u == gen * BAR_NG) {
#pragma unroll
        for (int j = 0; j < BAR_NG; ++j) __hip_atomic_store(bar + 6144 + 64 * j, gen, __ATOMIC_RELAXED, __HIP_MEMORY_SCOPE_AGENT);
      }
    }
    while (__hip_atomic_load(bar + 6144 + 64 * g, __ATOMIC_RELAXED, __HIP_MEMORY_SCOPE_AGENT) < gen) __builtin_amdgcn_s_sleep(1);
    __builtin_amdgcn_fence(__ATOMIC_ACQUIRE, "agent");
  }
  __syncthreads();
}
DI void group_barrier(unsigned* ctr, unsigned target) {
  __syncthreads();
  if (threadIdx.x == 0) {
    __builtin_amdgcn_fence(__ATOMIC_RELEASE, "agent");
    __hip_atomic_fetch_add(ctr, 1u, __ATOMIC_RELAXED, __HIP_MEMORY_SCOPE_AGENT);
    while (__hip_atomic_load(ctr, __ATOMIC_RELAXED, __HIP_MEMORY_SCOPE_AGENT) < target) __builtin_amdgcn_s_sleep(1);
    __builtin_amdgcn_fence(__ATOMIC_ACQUIRE, "agent");
  }
  __syncthreads();
}
#ifndef EXTRA_BAR
#define EXTRA_BAR 0
#endif
#ifndef DUP_BAR
#define DUP_BAR 0
#endif
template <int PH, int P1>
DI void run_from(const Params& p, char* smem, unsigned& gen) {
  if constexpr (PH == 0) {
    if (blockIdx.x == 0) { for (int i = threadIdx.x; i < 32768; i += NTHR) __hip_atomic_store((unsigned*)(p.ws + OFF_BAR) + i, 0u, __ATOMIC_RELAXED, __HIP_MEMORY_SCOPE_AGENT); }
  }
  if constexpr ((DUP_MASK >> PH) & 1) { run_phase<PH>(p, smem, 1, 0); if (DUP_BAR) grid_barrier((unsigned*)(p.ws + OFF_BAR) + 4096, ++gen); run_phase<PH>(p, smem, 0, 1); }
  else run_phase<PH>(p, smem);
  if constexpr (PH + 1 < P1) {
    if constexpr (PH == 0) cg::this_grid().sync();
    else if constexpr (PH == 4 || PH == 5 || PH == 9 || PH == 10) {
      if (gridDim.x == 256) {
        constexpr unsigned k = (PH == 4) ? 1u : (PH == 5) ? 2u : (PH == 9) ? 3u : 4u;
        const unsigned grp = (blockIdx.x & 7u) * 8u + ((blockIdx.x >> 3) & 7u);
        group_barrier((unsigned*)(p.ws + OFF_BAR) + 16384 + 64 * grp, 4u * k);
      } else {
        grid_barrier((unsigned*)(p.ws + OFF_BAR) + 4096, ++gen);
      }
    }
    else if constexpr (PH == 1 || PH == 3 || PH == 7) {
      if (gridDim.x == 256) group_barrier((unsigned*)(p.ws + OFF_BAR) + 24576 + 64 * (blockIdx.x & 7u), (PH == 1) ? 32u : (PH == 3) ? 64u : 96u);
      else grid_barrier((unsigned*)(p.ws + OFF_BAR) + 4096, ++gen);
    }
    else if constexpr (PH != 2) grid_barrier((unsigned*)(p.ws + OFF_BAR) + 4096, ++gen);
    if constexpr (PH == 3) { for (int i = 0; i < EXTRA_BAR; ++i) grid_barrier((unsigned*)(p.ws + OFF_BAR) + 4096, ++gen); }
    run_from<PH + 1, P1>(p, smem, gen);
  }
}
template <int P0, int P1>
__global__ void __launch_bounds__(NTHR) fwd_kernel(Params p) {
  __shared__ __attribute__((aligned(16))) char smem[163840];
  unsigned gen = 0;
  run_from<P0, P1>(p, smem, gen);
}

typedef void (*kern_t)(Params);

extern "C" void kernel_launch(void* const* d_in, const int* in_sizes, int n_in, void* d_out, int out_size, void* d_ws, size_t ws_size, hipStream_t stream) {
  static int grid_blocks = 0;
  if (!grid_blocks) {
    int dev = 0, cus = 0, per_cu = 0;
    (void)hipGetDevice(&dev);
    (void)hipDeviceGetAttribute(&cus, hipDeviceAttributeMultiprocessorCount, dev);
#if MK_SINGLE
    (void)hipOccupancyMaxActiveBlocksPerMultiprocessor(&per_cu, fwd_kernel<0, 12>, NTHR, 0);
#else
    per_cu = 1;
#endif
    if (per_cu < 1) per_cu = 1;
    if (cus < 1) cus = 256;
    grid_blocks = (cus * per_cu) & ~63;
  }
  Params p{};
  const float** f = (const float**)&p;
  for (int i = 0; i < 29; ++i) f[i] = (const float*)d_in[i];
  p.out = (float*)d_out; p.ws = (char*)d_ws;
#if MK_SINGLE
  void* args[] = {&p};
  hipError_t e = hipLaunchCooperativeKernel((void*)fwd_kernel<0, 12>, dim3(grid_blocks), dim3(NTHR), args, 0, stream);
  if (e != hipSuccess) fprintf(stderr, "cooperative launch failed: %s (grid %d)\n", hipGetErrorString(e), grid_blocks);
#else
  static const kern_t ks[12] = {fwd_kernel<0, 1>, fwd_kernel<1, 2>, fwd_kernel<2, 3>, fwd_kernel<3, 4>, fwd_kernel<4, 5>, fwd_kernel<5, 6>,
                                fwd_kernel<6, 7>, fwd_kernel<7, 8>, fwd_kernel<8, 9>, fwd_kernel<9, 10>, fwd_kernel<10, 11>, fwd_kernel<11, 12>};
  for (int ph = 0; ph < 12; ++ph) hipLaunchKernelGGL(ks[ph], dim3(grid_blocks), dim3(NTHR), 0, stream, p);
#endif
}
```

```cpp
#include <hip/hip_runtime.h>
#include <hip/hip_cooperative_groups.h>
#include <cstdio>
#include <cstdint>
namespace cg = cooperative_groups;

#ifndef MK_SINGLE
#define MK_SINGLE 1
#endif
#ifndef DUP_MASK
#define DUP_MASK 0
#endif
#ifndef ATTN_VAR
#define ATTN_VAR 0
#endif
#ifndef P2_VAR
#define P2_VAR 0
#endif

typedef unsigned short bf16_t;
typedef short bf16x8 __attribute__((ext_vector_type(8)));
typedef float f32x16 __attribute__((ext_vector_type(16)));
typedef __bf16 bf16x2_t __attribute__((ext_vector_type(2)));
typedef float f32x2_t __attribute__((ext_vector_type(2)));
typedef unsigned u32x4 __attribute__((ext_vector_type(4)));
#define DI __device__ __forceinline__
#define MFMA(a, b, c) __builtin_amdgcn_mfma_f32_32x32x16_bf16((a), (b), (c), 0, 0, 0)

constexpr int MT = 16384;
constexpr int DM = 1024;
constexpr int SEQ = 2048;
constexpr int DFF = 2816;
constexpr int NTHR = 512;
constexpr float LN_EPS = 1e-5f;
constexpr float DN_ALPHA = 1.4142135623730951f;
constexpr float LAMBDA_INIT = 0.35550906759096926f;

constexpr size_t MB = 1024 * 1024;
constexpr size_t OFF_W_IN = 0;
constexpr size_t OFF_W_OUT0 = OFF_W_IN + 4 * MB;
constexpr size_t OFF_W_GU0 = OFF_W_OUT0 + 2 * MB;
constexpr size_t OFF_W_DN0 = OFF_W_GU0 + (size_t)5632 * 1024 * 2;
constexpr size_t OFF_W_QKV = OFF_W_DN0 + (size_t)2816 * 1024 * 2;
constexpr size_t OFF_W_OUT1 = OFF_W_QKV + 6 * MB;
constexpr size_t OFF_W_GU1 = OFF_W_OUT1 + 2 * MB;
constexpr size_t OFF_W_DN1 = OFF_W_GU1 + (size_t)5632 * 1024 * 2;
constexpr size_t OFF_XB = OFF_W_DN1 + (size_t)2816 * 1024 * 2;
constexpr size_t OFF_MIX = OFF_XB + 32 * MB;
constexpr size_t OFF_REGA = OFF_MIX + 32 * MB;
constexpr size_t OFF_GB = OFF_REGA + 16 * MB;
constexpr size_t OFF_HLOC = OFF_REGA + 48 * MB;
constexpr size_t OFF_HID = OFF_REGA;
constexpr size_t OFF_Q = OFF_REGA;
constexpr size_t OFF_K = OFF_REGA + 32 * MB;
constexpr size_t OFF_VT = OFF_REGA + 64 * MB;
constexpr size_t OFF_PBUF = OFF_REGA + 96 * MB;
constexpr size_t OFF_GLU = OFF_PBUF;
constexpr size_t OFF_RB = OFF_PBUF + 16 * MB;
constexpr size_t OFF_AGG = OFF_PBUF + 32 * MB;
constexpr size_t OFF_ROPE = OFF_AGG + 2 * MB;
constexpr size_t OFF_BAR = OFF_ROPE + 1 * MB;
constexpr size_t OFF_PART = OFF_BAR + 1 * MB;
constexpr size_t OFF_WT = OFF_PART + 2 * MB;

struct Params {
  const float* x; const float* w_in; const float* b_in; const float* conv_w; const float* conv_b;
  const float* cn_g; const float* cn_b; const float* lconv_w; const float* lconv_b;
  const float* w_a; const float* b_a; const float* w_x; const float* b_x; const float* lru_lam; const float* w_out0;
  const float* w_qkv; const float* lq1; const float* lk1; const float* lq2; const float* lk2; const float* subln_g; const float* w_out1;
  const float* mix_g; const float* mix_b; const float* ffn_gate; const float* ffn_up; const float* ffn_down;
  const float* ffn_g; const float* ffn_b;
  float* out; char* ws;
};

DI unsigned pk2(float lo, float hi) { f32x2_t v = {lo, hi}; bf16x2_t b = __builtin_convertvector(v, bf16x2_t); return __builtin_bit_cast(unsigned, b); }
DI bf16_t f2bf(float x) { return (bf16_t)(pk2(x, 0.f) & 0xffffu); }
DI float bf2f(bf16_t b) { return __uint_as_float(((unsigned)b) << 16); }
DI int crow(int i, int h) { return (i & 3) + 8 * (i >> 2) + 4 * h; }
DI float sigmoid_(float x) { return __builtin_amdgcn_rcpf(1.f + __expf(-x)); }
DI float silu_(float x) { return x * sigmoid_(x); }
DI float gelu_tanh(float x) {
  float y = 0.7978845608028654f * (x + 0.044715f * x * x * x);
  float t = 1.f - 2.f * __builtin_amdgcn_rcpf(1.f + __expf(2.f * y));
  return 0.5f * x * (1.f + t);
}
DI unsigned lds_off(int row, int chunk) { return (unsigned)(row * 64 + (((chunk ^ (row >> 2)) & 3) << 4)); }
DI float xor_lane(float v, int mask, int lane) { return __int_as_float(__builtin_amdgcn_ds_bpermute((lane ^ mask) << 2, __float_as_int(v))); }
DI float half_max(float v) { auto r = __builtin_amdgcn_permlane32_swap(__float_as_uint(v), __float_as_uint(v), false, false); return fmaxf(__uint_as_float(r[0]), __uint_as_float(r[1])); }
DI float half_sum(float v) { auto r = __builtin_amdgcn_permlane32_swap(__float_as_uint(v), __float_as_uint(v), false, false); return __uint_as_float(r[0]) + __uint_as_float(r[1]); }
template <int CTRL, int ROW_MASK>
DI float dpp_add(float v) {
  return v + __int_as_float(__builtin_amdgcn_update_dpp(0, __float_as_int(v), CTRL, ROW_MASK, 0xf, false));
}
DI float wave_sum(float v, int  ) {
  v = dpp_add<0xB1, 0xf>(v);
  v = dpp_add<0x4E, 0xf>(v);
  v = dpp_add<0x141, 0xf>(v);
  v = dpp_add<0x140, 0xf>(v);
  v = dpp_add<0x142, 0xa>(v);
  v = dpp_add<0x143, 0xc>(v);
  return __int_as_float(__builtin_amdgcn_readlane(__float_as_int(v), 63));
}

DI void cvt_weight(bf16_t* __restrict__ dst, const float* __restrict__ s0, const float* __restrict__ s1,
                   int K, int Nsrc, int Np, int mode, int gtid, int gsz, char* smem) {
  const int total = (K / 32) * Np;
  const int lane = gtid & 63;
  char* wbuf = smem + ((gtid >> 6) & 7) * 4096;
  for (int idx = gtid; idx < total; idx += gsz) {
    const int kg = idx / Np, np = idx - kg * Np;
    const float* src = s0; int n = np;
    if (mode == 1) {
      const int blk = np >> 6, t = np & 63;
      if (blk < 16) n = (t < 32) ? (blk * 32 + t) : (512 + blk * 32 + (t - 32));
      else { const int j = blk - 16; n = (t < 32) ? (1024 + j * 32 + t) : (1536 + j * 32 + (t - 32)); }
    } else if (mode == 2) {
      const int blk = np >> 6, t = np & 63;
      src = (t < 32) ? s0 : s1; n = blk * 32 + (t & 31);
    }
    const float* p = src + (size_t)(kg * 32) * Nsrc + n;
    unsigned o[16];
#pragma unroll
    for (int kk = 0; kk < 16; ++kk) o[kk] = pk2(p[(size_t)(2 * kk) * Nsrc], p[(size_t)(2 * kk + 1) * Nsrc]);
#pragma unroll
    for (int e = 0; e < 4; ++e) *(u32x4*)(wbuf + lane * 64 + e * 16) = (u32x4){o[4 * e], o[4 * e + 1], o[4 * e + 2], o[4 * e + 3]};
    __builtin_amdgcn_wave_barrier();
    asm volatile("s_waitcnt lgkmcnt(0)" ::: "memory");
    char* d = (char*)(dst + (size_t)(idx - lane) * 32);
#pragma unroll
    for (int e = 0; e < 4; ++e) *(u32x4*)(d + e * 1024 + lane * 16) = *(const u32x4*)(wbuf + e * 1024 + lane * 16);
    __builtin_amdgcn_wave_barrier();
  }
}

DI void phase_prep(const Params& p, char* smem) {
  int tid0 = threadIdx.x;
  asm volatile("" : "+v"(tid0));
  const int gtid = blockIdx.x * NTHR + tid0, gsz = gridDim.x * NTHR;
  char* ws = p.ws;
  {
    bf16_t* xb = (bf16_t*)(ws + OFF_XB);
    for (int idx = gtid; idx < MT * 32; idx += gsz) {
      const int kg = idx >> 14, row = idx & (MT - 1);
      const float4* s = (const float4*)(p.x + (size_t)row * DM + kg * 32);
      uint4* d = (uint4*)(xb + ((size_t)kg * MT + row) * 32);
#pragma unroll
      for (int e = 0; e < 4; ++e) {
        float4 a = s[2 * e], b = s[2 * e + 1];
        d[e] = make_uint4(pk2(a.x, a.y), pk2(a.z, a.w), pk2(b.x, b.y), pk2(b.z, b.w));
      }
    }
  }
  cvt_weight((bf16_t*)(ws + OFF_W_IN), p.w_in, p.w_in, 1024, 2048, 2048, 1, gtid, gsz, smem);
  cvt_weight((bf16_t*)(ws + OFF_W_OUT0), p.w_out0, p.w_out0, 1024, 1024, 1024, 0, gtid, gsz, smem);
  cvt_weight((bf16_t*)(ws + OFF_W_GU0), p.ffn_gate, p.ffn_up, 1024, DFF, 2 * DFF, 2, gtid, gsz, smem);
  cvt_weight((bf16_t*)(ws + OFF_W_DN0), p.ffn_down, p.ffn_down, DFF, 1024, 1024, 0, gtid, gsz, smem);
  cvt_weight((bf16_t*)(ws + OFF_W_QKV), p.w_qkv, p.w_qkv, 1024, 3072, 3072, 0, gtid, gsz, smem);
  cvt_weight((bf16_t*)(ws + OFF_W_OUT1), p.w_out1, p.w_out1, 1024, 1024, 1024, 0, gtid, gsz, smem);
  cvt_weight((bf16_t*)(ws + OFF_W_GU1), p.ffn_gate + (size_t)1024 * DFF, p.ffn_up + (size_t)1024 * DFF, 1024, DFF, 2 * DFF, 2, gtid, gsz, smem);
  cvt_weight((bf16_t*)(ws + OFF_W_DN1), p.ffn_down + (size_t)DFF * 1024, p.ffn_down + (size_t)DFF * 1024, DFF, 1024, 1024, 0, gtid, gsz, smem);
  {
    bf16_t* wt = (bf16_t*)(ws + OFF_WT);
    for (int idx = gtid; idx < 2 * 8 * 64 * 8; idx += gsz) {
      const int i8 = idx & 7, j = (idx >> 3) & 63, g = (idx >> 9) & 7, gate = idx >> 12;
      const float* w = (gate ? p.w_x : p.w_a) + (size_t)(g * 64 + i8 * 8) * 64 + j;
      uint4 o = make_uint4(pk2(w[0], w[64]), pk2(w[128], w[192]), pk2(w[256], w[320]), pk2(w[384], w[448]));
      *(uint4*)(wt + (size_t)idx * 8) = o;
    }
  }
  {
    float2* tab = (float2*)(ws + OFF_ROPE);
    for (int idx = gtid; idx < SEQ * 32; idx += gsz) {
      const int pos = idx >> 5, j = idx & 31;
      const float inv = powf(10000.0f, -(float)j / 32.0f);
      const float ang = (float)pos * inv;
      double t = (double)ang * 0.15915494309189535;
      t -= rint(t);
      const float tf = (float)t;
      tab[idx] = make_float2(__builtin_amdgcn_cosf(tf), __builtin_amdgcn_sinf(tf));
    }
  }
}

#define WAITV(n) asm volatile("s_waitcnt vmcnt(" #n ")" ::: "memory")
template <int BM, int BN, int WR, int WC, int G, bool T2MAJOR, class Epi>
DI void gemm_phase(const bf16_t* __restrict__ P1, int R1, const bf16_t* __restrict__ P2, int R2, int K, char* smem, const Epi& epi, int tile_begin = 0, int tile_end = -1) {
  constexpr int MI = BM / WR / 32, NI = BN / WC / 32;
  static_assert((MI == 4 || MI == 2) && NI == 2 && (BM == 256 || BM == 128) && BN == 256, "256 (or 128) x 256 tile, wave tile 128 (or 64) x 64");
  constexpr int SPLIT = 256 / BM;
  constexpr int NDMA = (BM + BN) / 128;
  constexpr int STAGE = (BM + BN) * 64;
  int tid = threadIdx.x;
  asm volatile("" : "+v"(tid));
  const int lane = tid & 63, wave = __builtin_amdgcn_readfirstlane(tid >> 6);
  const int wr = wave / WC, wc = wave % WC;
  const int l32 = lane & 31, h = lane >> 5;
  const int tiles2 = R2 / BN, ntiles = (R1 / 256) * tiles2;
  if (tile_end < 0) tile_end = ntiles;
  const int KT = K / 32;
  const int srow = tid >> 2, schunk = (tid & 3) ^ ((tid >> 4) & 3);
  const unsigned soff = (unsigned)(srow * 32 + schunk * 8);
  const int tiles1 = R1 / 256;
  const bool xcd_order = (gridDim.x == 256) && (tiles1 % 64 == 0);
  const int ppx = tiles1 / 8;
  auto tile_origin = [&](int tile0, int& o1, int& o2) __attribute__((always_inline)) {
    int t1, t2;
    if (xcd_order) {
      const int xcd = tile0 & 7, lt = tile0 >> 3;
      const int grp = lt / (ppx * 4), rem = lt - grp * (ppx * 4);
      t2 = grp * 4 + rem / ppx; t1 = xcd * ppx + rem % ppx;
    } else {
      t1 = T2MAJOR ? (tile0 % tiles1) : (tile0 / tiles2); t2 = T2MAJOR ? (tile0 / tiles1) : (tile0 - t1 * tiles2);
    }
    o1 = t1 * 256; o2 = t2 * BN;
  };
  auto issue = [&](int kt, int o1, int o2) __attribute__((always_inline)) {
    const bf16_t* a1 = P1 + ((size_t)kt * R1 + o1) * 32;
    const bf16_t* a2 = P2 + ((size_t)kt * R2 + o2) * 32;
    char* l = smem + (kt & 3) * STAGE + tid * 16;
#pragma unroll
    for (int i = 0; i < BM / 128; ++i)
      __builtin_amdgcn_global_load_lds((const unsigned*)(a1 + i * 128 * 32 + soff), (__attribute__((address_space(3))) unsigned*)(l + i * 8192), 16, 0, 0);
#pragma unroll
    for (int i = 0; i < BN / 128; ++i)
      __builtin_amdgcn_global_load_lds((const unsigned*)(a2 + i * 128 * 32 + soff), (__attribute__((address_space(3))) unsigned*)(l + BM * 64 + i * 8192), 16, 0, 0);
  };
  bool pref = false;
  for (int u = tile_begin * SPLIT + blockIdx.x; u < tile_end * SPLIT; u += gridDim.x) {
    int o1, o2;
    int ut = u / SPLIT, uh = u % SPLIT;
    if (SPLIT == 2 && xcd_order && (tile_end - tile_begin) * 2 == 256) {
      const int v = u - tile_begin * SPLIT, xcd = v & 7, j = (v >> 3) & 7, m = v >> 6;
      ut = xcd + 8 * ((tile_begin >> 3) + (m >> 1) * 8 + j); uh = m & 1;
    }
    tile_origin(ut, o1, o2);
    o1 += uh * BM;

    f32x16 acc[MI][NI];
#pragma unroll
    for (int mi = 0; mi < MI; ++mi)
#pragma unroll
      for (int ni = 0; ni < NI; ++ni)
#pragma unroll
        for (int i = 0; i < 16; ++i) acc[mi][ni][i] = 0.f;

    if (!pref) {
      __syncthreads();
      issue(0, o1, o2); issue(1, o1, o2); issue(2, o1, o2);
      if constexpr (NDMA == 4) WAITV(8); else WAITV(6);
    } else {
      WAITV(0);
    }
    __builtin_amdgcn_s_barrier();
    if (wr == 1) __builtin_amdgcn_s_barrier();
    __builtin_amdgcn_sched_barrier(0);
    for (int kt = 0; kt < KT; ++kt) {
      const char* base = smem + (kt & 3) * STAGE;
#pragma unroll
      for (int ks = 0; ks < 2; ++ks) {
        const int chunk = ks * 2 + h;
        bf16x8 a[MI], b[NI];
#pragma unroll
        for (int mi = 0; mi < MI; ++mi) a[mi] = *(const bf16x8*)(base + lds_off(wr * (BM / WR) + mi * 32 + l32, chunk));
#pragma unroll
        for (int ni = 0; ni < NI; ++ni) b[ni] = *(const bf16x8*)(base + lds_off(BM + wc * (BN / WC) + ni * 32 + l32, chunk));
        if (ks == 1) {
          if (kt + 3 < KT) { issue(kt + 3, o1, o2); if constexpr (NDMA == 4) WAITV(8); else WAITV(6); }
          else if (kt + 2 < KT) { if constexpr (NDMA == 4) WAITV(4); else WAITV(3); }
          else WAITV(0);
        }
        __builtin_amdgcn_sched_barrier(0);
        __builtin_amdgcn_s_barrier();
        __builtin_amdgcn_sched_barrier(0);
        __builtin_amdgcn_s_setprio(1);
#pragma unroll
        for (int mi = 0; mi < MI; ++mi)
#pragma unroll
          for (int ni = 0; ni < NI; ++ni) acc[mi][ni] = MFMA(a[mi], b[ni], acc[mi][ni]);
        __builtin_amdgcn_s_setprio(0);
        __builtin_amdgcn_sched_barrier(0);
        __builtin_amdgcn_s_barrier();
        __builtin_amdgcn_sched_barrier(0);
      }
    }
    if (wr == 0) __builtin_amdgcn_s_barrier();
    __syncthreads();
    pref = false;
    if (!Epi::kUsesSmem && u + (int)gridDim.x < tile_end * SPLIT) {
      int n1, n2;
      tile_origin((u + (int)gridDim.x) / SPLIT, n1, n2);
      n1 += ((u + (int)gridDim.x) % SPLIT) * BM;
      issue(0, n1, n2); issue(1, n1, n2); issue(2, n1, n2);
      pref = true;
    }
    int lane_e = lane;
    asm volatile("" : "+v"(lane_e));
    epi(acc, o1 + wr * (BM / WR), o2 + wc * (BN / WC), lane_e, smem);
  }
}

struct EpiInProj {
  static constexpr bool kUsesSmem = false;
  const float* b_in; bf16_t* glu; bf16_t* gb; bf16_t* rb;
  DI void operator()(f32x16 (&acc)[4][2], int row0, int col0, int lane, char* smem) const {
    const int l32 = lane & 31, h = lane >> 5;
    const int blk = col0 >> 6;
    const bool isA = blk < 16;
    const int ch = (isA ? blk : blk - 16) * 32 + l32;
    const float b0 = b_in[(isA ? 0 : 1024) + ch], b1 = b_in[(isA ? 512 : 1536) + ch];
    if (isA) {
#pragma unroll
      for (int mi = 0; mi < 4; ++mi)
#pragma unroll
        for (int i = 0; i < 16; ++i) {
          const size_t row = row0 + mi * 32 + crow(i, h);
          const float v0 = acc[mi][0][i] + b0, v1 = acc[mi][1][i] + b1;
          glu[row * 512 + ch] = f2bf(v0 * sigmoid_(v1));
        }
    } else {
      const int wave = (int)__builtin_amdgcn_readfirstlane((int)(threadIdx.x >> 6));
      char* wbuf = smem + 131072 + wave * 4096;
      const size_t kg = (size_t)((512 + (blk - 16) * 32) >> 5);
#pragma unroll
      for (int mp = 0; mp < 2; ++mp) {
#pragma unroll
        for (int mm = 0; mm < 2; ++mm)
#pragma unroll
          for (int i = 0; i < 16; ++i) {
            const int mi = mp * 2 + mm;
            const size_t row = row0 + mi * 32 + crow(i, h);
            const float v0 = acc[mi][0][i] + b0, v1 = acc[mi][1][i] + b1;
            *(bf16_t*)(wbuf + (mm * 32 + crow(i, h)) * 64 + l32 * 2) = f2bf(gelu_tanh(v0));
            rb[row * 512 + ch] = f2bf(v1);
          }
        __builtin_amdgcn_wave_barrier();
        asm volatile("s_waitcnt lgkmcnt(0)" ::: "memory");
        char* d = (char*)(gb + (kg * MT + row0 + mp * 64) * 32);
#pragma unroll
        for (int e = 0; e < 4; ++e) *(u32x4*)(d + e * 1024 + lane * 16) = *(const u32x4*)(wbuf + e * 1024 + lane * 16);
        __builtin_amdgcn_wave_barrier();
      }
    }
  }
};
struct EpiSwiGLU {
  static constexpr bool kUsesSmem = false;
  bf16_t* hid;
  template <int MI>
  DI void operator()(f32x16 (&acc)[MI][2], int row0, int col0, int lane, char* smem) const {
    const int l32 = lane & 31, h = lane >> 5;
    const int wave = (int)__builtin_amdgcn_readfirstlane((int)(threadIdx.x >> 6));
    const size_t kg = col0 >> 6;
    char* wbuf = smem + 131072 + wave * 4096;
#pragma unroll
    for (int mp = 0; mp < MI / 2; ++mp) {
#pragma unroll
      for (int mm = 0; mm < 2; ++mm)
#pragma unroll
        for (int i = 0; i < 16; ++i) {
          const int r = mm * 32 + crow(i, h);
          *(bf16_t*)(wbuf + r * 64 + l32 * 2) = f2bf(silu_(acc[mp * 2 + mm][0][i]) * acc[mp * 2 + mm][1][i]);
        }
      __builtin_amdgcn_wave_barrier();
      asm volatile("s_waitcnt lgkmcnt(0)" ::: "memory");
      char* d = (char*)(hid + (kg * MT + row0 + mp * 64) * 32);
#pragma unroll
      for (int e = 0; e < 4; ++e) *(u32x4*)(d + e * 1024 + lane * 16) = *(const u32x4*)(wbuf + e * 1024 + lane * 16);
      __builtin_amdgcn_wave_barrier();
    }
  }
};
struct EpiQKV {
  static constexpr bool kUsesSmem = false;
  bf16_t* q; bf16_t* k; bf16_t* vt; const float2* rope; float qscale;
  DI void operator()(f32x16 (&acc)[4][2], int row0, int col0, int lane, char* smem) const {
    const int l32 = lane & 31, h = lane >> 5;
    const int wave = (int)__builtin_amdgcn_readfirstlane((int)(threadIdx.x >> 6));
    const int sect = col0 >> 10, within = col0 & 1023, head = within >> 7;
    const int b = row0 >> 11;
    char* wbuf = smem + 131072 + wave * 4096;
    if (sect < 2) {
      const int m = (within >> 6) & 1;
      bf16_t* dst = (sect == 0) ? q : k;
      const float sc = (sect == 0) ? qscale : 1.f;
      const int pos0 = row0 & (SEQ - 1);
#pragma unroll
      for (int mp = 0; mp < 2; ++mp) {
        float olo[2][16], ohi[2][16];
#pragma unroll
        for (int mm = 0; mm < 2; ++mm)
#pragma unroll
          for (int i = 0; i < 16; ++i) {
            const int pos = pos0 + (mp * 2 + mm) * 32 + crow(i, h);
            const float2 cs = rope[pos * 32 + l32];
            const float lo = acc[mp * 2 + mm][0][i], hi = acc[mp * 2 + mm][1][i];
            olo[mm][i] = (lo * cs.x - hi * cs.y) * sc; ohi[mm][i] = (hi * cs.x + lo * cs.y) * sc;
          }
#pragma unroll
        for (int gran = 0; gran < 2; ++gran) {
#pragma unroll
          for (int mm = 0; mm < 2; ++mm)
#pragma unroll
            for (int i = 0; i < 16; ++i)
              *(bf16_t*)(wbuf + (mm * 32 + crow(i, h)) * 64 + l32 * 2) = f2bf(gran ? ohi[mm][i] : olo[mm][i]);
          __builtin_amdgcn_wave_barrier();
          asm volatile("s_waitcnt lgkmcnt(0)" ::: "memory");
          char* d = (char*)(dst + (((size_t)((b * 8 + head) * 2 + m) * 2 + gran) * SEQ + pos0 + mp * 64) * 32);
#pragma unroll
          for (int e = 0; e < 4; ++e) *(u32x4*)(d + e * 1024 + lane * 16) = *(const u32x4*)(wbuf + e * 1024 + lane * 16);
          __builtin_amdgcn_wave_barrier();
        }
      }
    } else {
      const int vd0 = within & 127;
#pragma unroll
      for (int mi = 0; mi < 4; ++mi) {
        const int pos0 = (row0 + mi * 32) & (SEQ - 1);
        const size_t sg = pos0 >> 5;
#pragma unroll
        for (int ni = 0; ni < 2; ++ni)
#pragma unroll
          for (int jq = 0; jq < 4; ++jq) {
            const int ppos = 16 * (jq >> 1) + 8 * h + 4 * (jq & 1);
            const uint2 v = make_uint2(pk2(acc[mi][ni][4 * jq], acc[mi][ni][4 * jq + 1]), pk2(acc[mi][ni][4 * jq + 2], acc[mi][ni][4 * jq + 3]));
            *(uint2*)(wbuf + (ni * 32 + l32) * 64 + ppos * 2) = v;
          }
        __builtin_amdgcn_wave_barrier();
        asm volatile("s_waitcnt lgkmcnt(0)" ::: "memory");
        char* d = (char*)(vt + (((size_t)(b * 8 + head) * 64 + sg) * 128 + vd0) * 32);
#pragma unroll
        for (int e = 0; e < 4; ++e) *(u32x4*)(d + e * 1024 + lane * 16) = *(const u32x4*)(wbuf + e * 1024 + lane * 16);
        __builtin_amdgcn_wave_barrier();
      }
    }
  }
};
template <int X> DI float swz_xor(float v) { return __int_as_float(__builtin_amdgcn_ds_swizzle(__float_as_int(v), 0x1f | (X << 10))); }
DI void reduce_scatter32(float (&v)[32], int l32) {
  { const bool up = (l32 & 16) != 0;
#pragma unroll
    for (int j = 0; j < 16; ++j) { const float keep = up ? v[j + 16] : v[j], send = up ? v[j] : v[j + 16]; v[j] = keep + swz_xor<16>(send); } }
  { const bool up = (l32 & 8) != 0;
#pragma unroll
    for (int j = 0; j < 8; ++j) { const float keep = up ? v[j + 8] : v[j], send = up ? v[j] : v[j + 8]; v[j] = keep + swz_xor<8>(send); } }
  { const bool up = (l32 & 4) != 0;
#pragma unroll
    for (int j = 0; j < 4; ++j) { const float keep = up ? v[j + 4] : v[j], send = up ? v[j] : v[j + 4]; v[j] = keep + swz_xor<4>(send); } }
  { const bool up = (l32 & 2) != 0;
#pragma unroll
    for (int j = 0; j < 2; ++j) { const float keep = up ? v[j + 2] : v[j], send = up ? v[j] : v[j + 2]; v[j] = keep + swz_xor<2>(send); } }
  { const bool up = (l32 & 1) != 0;
    const float keep = up ? v[1] : v[0], send = up ? v[0] : v[1]; v[0] = keep + swz_xor<1>(send); }
}
template <bool FINAL>
struct EpiLN {
  static constexpr bool kUsesSmem = true;
  float* outf; bf16_t* xb; const float* g; const float* bt; float* part; unsigned* flag; int dry; int pass;
  DI void operator()(f32x16 (&acc)[4][2], int row0, int col0, int lane, char* smem) const {
    const int l32 = lane & 31, h = lane >> 5;
    const int wave = (int)__builtin_amdgcn_readfirstlane((int)(threadIdx.x >> 6));
    const int tid_e = wave * 64 + lane;
    const int tb = row0 >> 8, wr = (row0 >> 7) & 1, fb = col0 >> 8, wc = (col0 >> 6) & 3;
    float* T = (float*)smem;
    float2* sred = (float2*)(smem + 131072);
    float2* sstat = (float2*)(smem + 133120);
    const size_t colg = (size_t)fb * 256 + lane * 4;
    bf16_t* xq = xb + ((size_t)(fb * 8 + (lane >> 3)) * MT) * 32 + (lane & 7) * 4;
    float* sgb = (float*)(smem + 135168);
    if (tid_e < 256) { sgb[tid_e] = g[fb * 256 + tid_e]; sgb[256 + tid_e] = bt[fb * 256 + tid_e]; }
#pragma unroll 1
    for (int hh = 0; hh < 2; ++hh) {
      uint2 rres[16];
      {
        const bf16_t* xr = xq + ((size_t)tb * 256 + hh * 128 + wave * 16) * 32;
#pragma unroll
        for (int rr = 0; rr < 16; ++rr) rres[rr] = *(const uint2*)(xr + rr * 32);
      }
      if (wr == hh) {
        float* tw = T + (4 * h) * 256 + wc * 64 + l32;
#pragma unroll
        for (int mi = 0; mi < 4; ++mi)
#pragma unroll
          for (int i = 0; i < 16; ++i) {
            const int rc = mi * 32 + 8 * (i >> 2) + (i & 3);
            tw[rc * 256] = acc[mi][0][i];
            tw[rc * 256 + 32] = acc[mi][1][i];
          }
      }
      __syncthreads();
#pragma unroll
      for (int rr = 0; rr < 16; ++rr) {
        const int rl = wave * 16 + rr;
        const float4 a = *(const float4*)(T + rl * 256 + lane * 4);
        const uint2 rv = rres[rr];
        float4 z;
        z.x = a.x + DN_ALPHA * __uint_as_float(rv.x << 16); z.y = a.y + DN_ALPHA * __uint_as_float(rv.x & 0xffff0000u);
        z.z = a.z + DN_ALPHA * __uint_as_float(rv.y << 16); z.w = a.w + DN_ALPHA * __uint_as_float(rv.y & 0xffff0000u);
        *(float4*)(T + rl * 256 + lane * 4) = z;
        float s = (z.x + z.y) + (z.z + z.w), q = (z.x * z.x + z.y * z.y) + (z.z * z.z + z.w * z.w);
        s = wave_sum(s, lane); q = wave_sum(q, lane);
        if (lane == 0) sred[rl] = make_float2(s, q);
      }
      __syncthreads();
      if (tid_e < 128) {
        const float2 sv = sred[tid_e];
        const unsigned long long bits = ((unsigned long long)__float_as_uint(sv.y) << 32) | __float_as_uint(sv.x);
        __hip_atomic_store((unsigned long long*)(part + ((size_t)(tb * 4 + fb) * 256 + hh * 128 + tid_e) * 2), bits, __ATOMIC_RELAXED, __HIP_MEMORY_SCOPE_AGENT);
        asm volatile("s_waitcnt vmcnt(0)" ::: "memory");
      }
      __syncthreads();
      if (tid_e == 0) {
        __hip_atomic_fetch_add(flag + tb, 1u, __ATOMIC_RELAXED, __HIP_MEMORY_SCOPE_AGENT);
        while (__hip_atomic_load(flag + tb, __ATOMIC_RELAXED, __HIP_MEMORY_SCOPE_AGENT) < 4u * (hh + 1) + 8u * (unsigned)pass) __builtin_amdgcn_s_sleep(1);
      }
      __syncthreads();
      if (tid_e < 128) {
        float a = 0.f, a2 = 0.f;
#pragma unroll
        for (int j = 0; j < 4; ++j) {
          const unsigned long long bits = __hip_atomic_load((const unsigned long long*)(part + ((size_t)(tb * 4 + j) * 256 + hh * 128 + tid_e) * 2), __ATOMIC_RELAXED, __HIP_MEMORY_SCOPE_AGENT);
          a += __uint_as_float((unsigned)bits); a2 += __uint_as_float((unsigned)(bits >> 32));
        }
        const float mean = a * (1.f / 1024.f);
        const float var = fmaxf(a2 * (1.f / 1024.f) - mean * mean, 0.f);
        sstat[tid_e] = make_float2(mean, rsqrtf(var + LN_EPS));
      }
      __syncthreads();
      if (FINAL) {
        const float4 gg = *(const float4*)(g + colg), bb = *(const float4*)(bt + colg);
#pragma unroll 1
        for (int rr = 0; rr < 16; ++rr) {
          const int rl = wave * 16 + rr;
          const size_t row = (size_t)tb * 256 + hh * 128 + rl;
          const float2 st = sstat[rl];
          const float4 z = *(const float4*)(T + rl * 256 + lane * 4);
          float4 o;
          o.x = (z.x - st.x) * st.y * gg.x + bb.x; o.y = (z.y - st.x) * st.y * gg.y + bb.y;
          o.z = (z.z - st.x) * st.y * gg.z + bb.z; o.w = (z.w - st.x) * st.y * gg.w + bb.w;
          *(float4*)(outf + row * DM + colg) = o;
        }
      } else if (!dry) {
        const int r = lane >> 2, pc = lane & 3, rl = wave * 16 + r;
        const float2 st = sstat[rl];
        const size_t row = (size_t)tb * 256 + hh * 128 + rl;
#pragma unroll 2
        for (int gq = 0; gq < 8; ++gq) {
          const int c0 = gq * 32 + pc * 8;
          const float4 z0 = *(const float4*)(T + rl * 256 + c0), z1 = *(const float4*)(T + rl * 256 + c0 + 4);
          const float4 g0 = *(const float4*)(sgb + c0), g1 = *(const float4*)(sgb + c0 + 4);
          const float4 b0 = *(const float4*)(sgb + 256 + c0), b1 = *(const float4*)(sgb + 256 + c0 + 4);
          const u32x4 o = {pk2((z0.x - st.x) * st.y * g0.x + b0.x, (z0.y - st.x) * st.y * g0.y + b0.y),
                           pk2((z0.z - st.x) * st.y * g0.z + b0.z, (z0.w - st.x) * st.y * g0.w + b0.w),
                           pk2((z1.x - st.x) * st.y * g1.x + b1.x, (z1.y - st.x) * st.y * g1.y + b1.y),
                           pk2((z1.z - st.x) * st.y * g1.z + b1.z, (z1.w - st.x) * st.y * g1.w + b1.w)};
          *(u32x4*)(xb + ((size_t)(fb * 8 + gq) * MT + row) * 32 + pc * 8) = o;
        }
      }
      __syncthreads();
    }
  }
};

template <int VAR>
DI void phase_convlru(const Params& p, char* smem) {
  int tid = threadIdx.x;
  asm volatile("" : "+v"(tid));
  const int lane = tid & 63, wave = tid >> 6;
  const int c = tid;
  char* ws = p.ws;
  const bf16_t* glu = (const bf16_t*)(ws + OFF_GLU);
  const bf16_t* rbuf = (const bf16_t*)(ws + OFF_RB);
  const bf16_t* gbuf = (const bf16_t*)(ws + OFF_GB);
  float2* agg = (float2*)(ws + OFF_AGG);
  unsigned* lflag = (unsigned*)(ws + OFF_BAR) + 512;
  bf16_t* mix = (bf16_t*)(ws + (VAR ? OFF_HLOC : OFF_MIX));
  bf16_t* sA = (bf16_t*)smem;
  float* sOut = (float*)(smem + 63488);
  bf16_t* sR = (bf16_t*)smem;
  constexpr int RS = 516;
  float* sRf = (float*)(smem + 36864);

  const bool own_batch = (gridDim.x == 256);
  for (int it = blockIdx.x; it < 512; it += gridDim.x) {
    const int item = own_batch ? (((it & 7) << 6) | ((it >> 3) & 31) | ((it >> 8) << 5)) : it;
    const int b = item >> 6, ft = item & 63, t0 = ft * 32;
    const size_t rowbase = (size_t)b * SEQ;
    __syncthreads();
    if (VAR != 1) {
    for (int q = tid; q < 62 * 64; q += NTHR) {
      const int r = q >> 6, cc = q & 63, fr = t0 - 30 + r;
      uint4 v = make_uint4(0, 0, 0, 0);
      if (fr >= 0) v = *(const uint4*)(glu + (rowbase + fr) * 512 + cc * 8);
      *(uint4*)(sA + r * 512 + cc * 8) = v;
    }
    __syncthreads();
    {
      int cq = c;
      asm volatile("" : "+v"(cq));
      float cw[31];
#pragma unroll
      for (int j = 0; j < 31; ++j) cw[j] = p.conv_w[j * 512 + cq];
      const float cb = p.conv_b[cq];
      float xin[62];
#pragma unroll
      for (int r = 0; r < 62; ++r) xin[r] = bf2f(sA[r * 512 + c]);
#pragma unroll
      for (int t = 0; t < 32; ++t) {
        float a = cb;
#pragma unroll
        for (int j = 0; j < 31; ++j) a += cw[j] * xin[t + j];
        sOut[t * 512 + c] = a;
      }
    }
    __syncthreads();
    for (int t = wave * 4; t < wave * 4 + 4; ++t) {
      float v[8]; float s = 0.f;
#pragma unroll
      for (int e = 0; e < 8; ++e) { v[e] = sOut[t * 512 + e * 64 + lane]; s += v[e]; }
      s = wave_sum(s, lane);
      const float mean = s * (1.f / 512.f);
      float s2 = 0.f;
#pragma unroll
      for (int e = 0; e < 8; ++e) { const float d = v[e] - mean; s2 += d * d; }
      s2 = wave_sum(s2, lane);
      const float rstd = rsqrtf(s2 * (1.f / 512.f) + LN_EPS);
      const size_t row = rowbase + t0 + t;
#pragma unroll
      for (int e = 0; e < 8; ++e) {
        const int ch = e * 64 + lane;
        const float y = (v[e] - mean) * rstd * p.cn_g[ch] + p.cn_b[ch];
        mix[((size_t)(ch >> 5) * MT + row) * 32 + (ch & 31)] = f2bf(silu_(y));
      }
    }
    __syncthreads();
    }
    if (VAR != 2) {
    for (int q = tid; q < 35 * 64; q += NTHR) {
      const int r = q >> 6, cc = q & 63, fr = t0 - 3 + r;
      uint4 v = make_uint4(0, 0, 0, 0);
      if (fr >= 0) v = *(const uint4*)(rbuf + (rowbase + fr) * 512 + cc * 8);
      *(uint4*)(sR + r * 512 + cc * 8) = v;
    }
    __syncthreads();
    {
      const float w0 = p.lconv_w[c], w1 = p.lconv_w[512 + c], w2 = p.lconv_w[1024 + c], w3 = p.lconv_w[1536 + c];
      const float lb = p.lconv_b[c];
      for (int t = 0; t < 32; ++t) {
        float a = lb;
        a += w0 * bf2f(sR[(t + 0) * 512 + c]);
        a += w1 * bf2f(sR[(t + 1) * 512 + c]);
        a += w2 * bf2f(sR[(t + 2) * 512 + c]);
        a += w3 * bf2f(sR[(t + 3) * 512 + c]);
        sRf[t * RS + c] = a;
      }
    }
    __syncthreads();
    {
      const int g = wave, l32 = lane & 31, h = lane >> 5;
      const bf16_t* wt = (const bf16_t*)(ws + OFF_WT);
      bf16x8 af[4];
#pragma unroll
      for (int ks = 0; ks < 4; ++ks) {
        const float4 lo = *(const float4*)(sRf + l32 * RS + g * 64 + ks * 16 + 8 * h);
        const float4 hi = *(const float4*)(sRf + l32 * RS + g * 64 + ks * 16 + 8 * h + 4);
        const u32x4 pw = {pk2(lo.x, lo.y), pk2(lo.z, lo.w), pk2(hi.x, hi.y), pk2(hi.z, hi.w)};
        af[ks] = __builtin_bit_cast(bf16x8, pw);
      }
      f32x16 ga[2][2];
#pragma unroll
      for (int gate = 0; gate < 2; ++gate)
#pragma unroll
        for (int nt = 0; nt < 2; ++nt) {
#pragma unroll
          for (int i = 0; i < 16; ++i) ga[gate][nt][i] = 0.f;
#pragma unroll
          for (int ks = 0; ks < 4; ++ks) {
            const bf16x8 bfrag = *(const bf16x8*)(wt + ((size_t)((gate * 8 + g) * 64 + nt * 32 + l32)) * 64 + ks * 16 + 8 * h);
            ga[gate][nt] = MFMA(af[ks], bfrag, ga[gate][nt]);
          }
        }
      float av[2][16], uv[2][16];
#pragma unroll
      for (int nt = 0; nt < 2; ++nt) {
        const int cc = g * 64 + nt * 32 + l32;
        const float ba = p.b_a[cc], bx = p.b_x[cc];
        const float sp = log1pf(__expf(-p.lru_lam[cc]));
#pragma unroll
        for (int i = 0; i < 16; ++i) {
          const int t = crow(i, h);
          const float rme = sRf[t * RS + cc];
          const float gr = sigmoid_(ga[0][nt][i] + ba), gi = sigmoid_(ga[1][nt][i] + bx);
          const float la = -8.0f * gr * sp;
          const float a = __expf(la);
          av[nt][i] = a;
          uv[nt][i] = sqrtf(fmaxf(1.f - a * a, 0.f)) * (gi * rme);
        }
      }
      __syncthreads();
      float* sAa = (float*)smem;
      float* sU = (float*)(smem + 65536);
#pragma unroll
      for (int nt = 0; nt < 2; ++nt)
#pragma unroll
        for (int i = 0; i < 16; ++i) {
          const int t = crow(i, h), cc = g * 64 + nt * 32 + l32;
          sAa[t * 512 + cc] = av[nt][i];
          sU[t * 512 + cc] = uv[nt][i];
        }
      __syncthreads();
      float hcur = 0.f, pcur = 1.f;
      float hl[32], pl[32];
#pragma unroll
      for (int t = 0; t < 32; ++t) {
        const float a = sAa[t * 512 + c], u = sU[t * 512 + c];
        hcur = a * hcur + u;
        pcur *= a;
        hl[t] = hcur; pl[t] = pcur;
      }
      {
        const unsigned long long bits = ((unsigned long long)__float_as_uint(hcur) << 32) | __float_as_uint(pcur);
        __hip_atomic_store((unsigned long long*)(agg + (size_t)(b * 64 + ft) * 512 + c), bits, __ATOMIC_RELAXED, __HIP_MEMORY_SCOPE_AGENT);
        asm volatile("s_waitcnt vmcnt(0)" ::: "memory");
      }
      __syncthreads();
      if (tid < 64) {
        if (tid == 0) __hip_atomic_store(lflag + b * 64 + ft, 1u, __ATOMIC_RELAXED, __HIP_MEMORY_SCOPE_AGENT);
        if (tid < ft)
          while (__hip_atomic_load(lflag + b * 64 + tid, __ATOMIC_RELAXED, __HIP_MEMORY_SCOPE_AGENT) == 0u) __builtin_amdgcn_s_sleep(1);
      }
      __syncthreads();
      float carry = 0.f;
#pragma unroll 16
      for (int i = 0; i < ft; ++i) {
        const unsigned long long bits = __hip_atomic_load((const unsigned long long*)(agg + (size_t)(b * 64 + i) * 512 + c), __ATOMIC_RELAXED, __HIP_MEMORY_SCOPE_AGENT);
        carry = __uint_as_float((unsigned)bits) * carry + __uint_as_float((unsigned)(bits >> 32));
      }
#pragma unroll
      for (int t = 0; t < 32; ++t) {
        const size_t row = rowbase + t0 + t;
        bf16_t* slot = mix + ((size_t)((512 + c) >> 5) * MT + row) * 32 + (c & 31);
        *slot = f2bf((hl[t] + pl[t] * carry) * bf2f(*slot));
      }
    }
    }
  }
}

DI void phase_lrufix(const Params& p) {
  int c = threadIdx.x;
  asm volatile("" : "+v"(c));
  char* ws = p.ws;
  const bf16_t* gb = (const bf16_t*)(ws + OFF_GB);
  const float* hloc = (const float*)(ws + OFF_HLOC);
  const float* pbuf = (const float*)(ws + OFF_PBUF);
  const float2* agg = (const float2*)(ws + OFF_AGG);
  bf16_t* mix = (bf16_t*)(ws + OFF_MIX);
  for (int item = blockIdx.x; item < 512; item += gridDim.x) {
    const int b = item >> 6, ft = item & 63;
    float carry = 0.f;
#pragma unroll 8
    for (int i = 0; i < ft; ++i) { const float2 a = agg[(size_t)(b * 64 + i) * 512 + c]; carry = a.x * carry + a.y; }
    const size_t row0 = (size_t)b * SEQ + ft * 32;
#pragma unroll 4
    for (int t = 0; t < 32; ++t) {
      const size_t row = row0 + t;
      const float hh = hloc[row * 512 + c] + pbuf[row * 512 + c] * carry;
      const float y = hh * bf2f(gb[row * 512 + c]);
      mix[((size_t)((512 + c) >> 5) * MT + row) * 32 + (c & 31)] = f2bf(y);
    }
  }
}

template <int VAR>
DI void phase_attn(const Params& p, char* smem) {
  int tid = threadIdx.x;
  asm volatile("" : "+v"(tid));
  const int lane = tid & 63, wave = __builtin_amdgcn_readfirstlane(tid >> 6);
  const int l32 = lane & 31, h = lane >> 5;
  char* ws = p.ws;
  const bf16_t* qb = (const bf16_t*)(ws + OFF_Q);
  const bf16_t* kb_ = (const bf16_t*)(ws + OFF_K);
  const bf16_t* vt = (const bf16_t*)(ws + OFF_VT);
  bf16_t* mix = (bf16_t*)(ws + (VAR ? OFF_HLOC : OFF_MIX));
  float d1 = 0.f, d2 = 0.f;
  for (int i = 0; i < 64; ++i) { d1 += p.lq1[i] * p.lk1[i]; d2 += p.lq2[i] * p.lk2[i]; }
  const float lam = expf(d1) - expf(d2) + LAMBDA_INIT;
  constexpr int STAGE = 512 * 64;
  constexpr int QOFF = 3 * STAGE;

  for (int pr = blockIdx.x; pr < 256; pr += gridDim.x) {
    for (int half = 0; half < 2; ++half) {
      int qblk, bh;
      if (gridDim.x == 256) {
        const int qp = pr >> 6;
        qblk = half ? (7 - qp) : qp; bh = ((pr & 7) << 3) | ((pr >> 3) & 7);
      } else {
        const int id = half ? (511 - pr) : pr;
        qblk = id >> 6; bh = id & 63;
      }
      const int q0 = qblk * 256;
      const int T = q0 / 64 + 4;
      const int ntw = (q0 + wave * 32) / 64 + 1;
      const size_t kbase = (size_t)bh * 4 * SEQ * 32;
      const size_t vbase = (size_t)bh * 64 * 128 * 32;

      const int schunk = (tid & 3) ^ ((tid >> 4) & 3);
      const unsigned koff0 = (unsigned)(((tid >> 8) * SEQ + ((tid >> 2) & 63)) * 32 + schunk * 8);
      const unsigned voff0 = (unsigned)((tid >> 2) * 32 + schunk * 8);
      auto issueKV = [&](int t, int stg) __attribute__((always_inline)) {
        char* l = smem + stg * STAGE + tid * 16;
        unsigned k0 = koff0, v0 = voff0;
        asm volatile("" : "+v"(k0), "+v"(v0));
        const bf16_t* gk = kb_ + kbase + (size_t)t * 64 * 32;
        const bf16_t* gv = vt + vbase + (size_t)t * 2 * 128 * 32;
        __builtin_amdgcn_global_load_lds((const unsigned*)(gk + k0), (__attribute__((address_space(3))) unsigned*)(l), 16, 0, 0);
        __builtin_amdgcn_global_load_lds((const unsigned*)(gk + (k0 + 2u * SEQ * 32u)), (__attribute__((address_space(3))) unsigned*)(l + 8192), 16, 0, 0);
        __builtin_amdgcn_global_load_lds((const unsigned*)(gv + v0), (__attribute__((address_space(3))) unsigned*)(l + 16384), 16, 0, 0);
        __builtin_amdgcn_global_load_lds((const unsigned*)(gv + (v0 + 128u * 32u)), (__attribute__((address_space(3))) unsigned*)(l + 24576), 16, 0, 0);
      };

      __syncthreads();
      int tq = tid;
      asm volatile("" : "+v"(tq));
#pragma unroll
      for (int bt = 0; bt < 2; ++bt) {
        u32x4 rq[4];
#pragma unroll
        for (int i = 0; i < 4; ++i) {
          const int q = tq + (bt * 4 + i) * NTHR, row = q >> 2, c = q & 3;
          rq[i] = *(const u32x4*)(qb + kbase + (size_t)q0 * 32 + (unsigned)(((row >> 8) * SEQ + (row & 255)) * 32 + c * 8));
        }
#pragma unroll
        for (int i = 0; i < 4; ++i) {
          const int q = tq + (bt * 4 + i) * NTHR, row = q >> 2, c = q & 3;
          *(u32x4*)(smem + QOFF + lds_off(row, c)) = rq[i];
        }
      }
      issueKV(0, 0); issueKV(1, 1);
      WAITV(4);
      asm volatile("s_waitcnt lgkmcnt(0)" ::: "memory");
      __builtin_amdgcn_s_barrier();
      asm volatile("" ::: "memory");

      float mx[2] = {-1e30f, -1e30f}, ls[2] = {0.f, 0.f};
      f32x16 O[2][4];
#pragma unroll
      for (int m = 0; m < 2; ++m)
#pragma unroll
        for (int mi = 0; mi < 4; ++mi)
#pragma unroll
          for (int i = 0; i < 16; ++i) O[m][mi][i] = 0.f;

      int stg = 0;
      for (int t = 0; t < T; ++t) {
        if (t + 2 < T) issueKV(t + 2, stg == 0 ? 2 : stg - 1);
        const char* base = smem + stg * STAGE;
        if (t < ntw && VAR != 3) {
#pragma unroll
          for (int kb = 0; kb < 2; ++kb) {
            unsigned pk[2][8];
#pragma unroll
            for (int m = 0; m < 2; ++m) {
              f32x16 S;
#pragma unroll
              for (int i = 0; i < 16; ++i) S[i] = 0.f;
              bf16x8 ka[4], qf[4];
#pragma unroll
              for (int ks = 0; ks < 4; ++ks) {
                ka[ks] = *(const bf16x8*)(base + lds_off((m * 2 + (ks >> 1)) * 64 + kb * 32 + l32, (ks & 1) * 2 + h));
                qf[ks] = *(const bf16x8*)(smem + QOFF + lds_off((m * 2 + (ks >> 1)) * 256 + wave * 32 + l32, (ks & 1) * 2 + h));
              }
              __builtin_amdgcn_sched_barrier(0);
#pragma unroll
              for (int ks = 0; ks < 4; ++ks) S = MFMA(ka[ks], qf[ks], S);
              float tm = fmaxf(S[0], S[1]);
#pragma unroll
              for (int i = 2; i < 16; i += 2) tm = fmaxf(fmaxf(tm, S[i]), S[i + 1]);
              tm = half_max(tm);
              const float mn = fmaxf(mx[m], tm);
              if (__builtin_amdgcn_ballot_w64(mn > mx[m]) != 0) {
                const float sc = __builtin_amdgcn_exp2f(mx[m] - mn);
                ls[m] *= sc;
#pragma unroll
                for (int mi = 0; mi < 4; ++mi)
#pragma unroll
                  for (int i = 0; i < 16; ++i) O[m][mi][i] *= sc;
                mx[m] = mn;
              }
              const f32x2_t mn2 = {mx[m], mx[m]};
              f32x2_t accv = {0.f, 0.f};
#pragma unroll
              for (int i = 0; i < 8; ++i) {
                const f32x2_t d = (f32x2_t){S[2 * i], S[2 * i + 1]} - mn2;
                const f32x2_t e = (VAR == 1) ? d : (f32x2_t){__builtin_amdgcn_exp2f(d.x), __builtin_amdgcn_exp2f(d.y)};
                accv += e;
                pk[m][i] = pk2(e.x, e.y);
              }
              ls[m] += accv.x + accv.y;
            }
#pragma unroll
            for (int s = 0; s < 2; ++s) {
              const u32x4 pw0 = {pk[0][4 * s + 0], pk[0][4 * s + 1], pk[0][4 * s + 2], pk[0][4 * s + 3]};
              const u32x4 pw1 = {pk[1][4 * s + 0], pk[1][4 * s + 1], pk[1][4 * s + 2], pk[1][4 * s + 3]};
              const bf16x8 pf0 = __builtin_bit_cast(bf16x8, pw0), pf1 = __builtin_bit_cast(bf16x8, pw1);
              bf16x8 va[4];
#pragma unroll
              for (int mi = 0; mi < 4; ++mi) va[mi] = *(const bf16x8*)(base + lds_off(256 + kb * 128 + mi * 32 + l32, 2 * s + h));
              __builtin_amdgcn_sched_barrier(0);
#pragma unroll
              for (int mi = 0; mi < 4; ++mi) {
                if (VAR != 2) { O[0][mi] = MFMA(va[mi], pf0, O[0][mi]); O[1][mi] = MFMA(va[mi], pf1, O[1][mi]); }
                else { O[0][mi][0] += __builtin_bit_cast(float, pf0[0] + va[mi][0]); O[1][mi][0] += __builtin_bit_cast(float, pf1[1] + va[mi][1]); }
              }
            }
          }
        }
        if (t + 2 < T) WAITV(4); else WAITV(0);
        __builtin_amdgcn_s_barrier();
        asm volatile("" ::: "memory");
        stg = (stg == 2) ? 0 : stg + 1;
      }
      const float l0 = half_sum(ls[0]), l1 = half_sum(ls[1]);
      const float c0 = 1.f / l0, c1 = lam / l1;
      float ssq = 0.f;
#pragma unroll
      for (int mi = 0; mi < 4; ++mi)
#pragma unroll
        for (int i = 0; i < 16; ++i) { const float o = O[0][mi][i] * c0 - O[1][mi][i] * c1; ssq += o * o; }
      ssq = half_sum(ssq);
      const float rs = rsqrtf(ssq * (1.f / 128.f) + LN_EPS) * (1.f - LAMBDA_INIT);
      const int bb = bh >> 3, head = bh & 7;
      const unsigned tok0 = (unsigned)(bb * SEQ + q0 + wave * 32);
      char* wbuf = smem + wave * 8192;
#pragma unroll
      for (int mi = 0; mi < 4; ++mi)
#pragma unroll
        for (int jq = 0; jq < 4; ++jq) {
          const int vd = mi * 32 + 8 * jq + 4 * h;
          const float4 gg = *(const float4*)(p.subln_g + vd);
          const float e0 = O[0][mi][4 * jq + 0] * c0 - O[1][mi][4 * jq + 0] * c1, e1 = O[0][mi][4 * jq + 1] * c0 - O[1][mi][4 * jq + 1] * c1;
          const float e2 = O[0][mi][4 * jq + 2] * c0 - O[1][mi][4 * jq + 2] * c1, e3 = O[0][mi][4 * jq + 3] * c0 - O[1][mi][4 * jq + 3] * c1;
          const unsigned w0 = pk2(e0 * rs * gg.x, e1 * rs * gg.y);
          const unsigned w1 = pk2(e2 * rs * gg.z, e3 * rs * gg.w);
          *(uint2*)(wbuf + mi * 2048 + l32 * 64 + (vd & 31) * 2) = make_uint2(w0, w1);
        }
      __builtin_amdgcn_wave_barrier();
      asm volatile("s_waitcnt lgkmcnt(0)" ::: "memory");
#pragma unroll
      for (int mi = 0; mi < 4; ++mi) {
        char* d = (char*)(mix + (unsigned)(((head * 4 + mi) * MT + tok0) * 32));
#pragma unroll
        for (int e2i = 0; e2i < 2; ++e2i) *(u32x4*)(d + e2i * 1024 + lane * 16) = *(const u32x4*)(wbuf + mi * 2048 + e2i * 1024 + lane * 16);
      }
      __builtin_amdgcn_wave_barrier();
    }
  }
}

template <int PH>
DI void run_phase(const Params& p, char* smem, int dry = 0, int pass = 0) {
  char* ws = p.ws;
  const bf16_t* xb = (const bf16_t*)(ws + OFF_XB);
  const bf16_t* mixb = (const bf16_t*)(ws + OFF_MIX);
  if constexpr (PH == 0) phase_prep(p, smem);
  if constexpr (PH == 1) {
    EpiInProj e{p.b_in, (bf16_t*)(ws + OFF_GLU), (bf16_t*)(ws + OFF_MIX), (bf16_t*)(ws + OFF_RB)};
    gemm_phase<256, 256, 2, 4, 2, false>(xb, MT, (const bf16_t*)(ws + OFF_W_IN), 2048, 1024, smem, e);
  }
  if constexpr (PH == 2) { if (P2_VAR != 0 && pass == 1) phase_convlru<P2_VAR>(p, smem); else phase_convlru<0>(p, smem); }
  if constexpr (PH == 4) {
    EpiLN<false> e{p.out, (bf16_t*)(ws + OFF_XB), p.mix_g, p.mix_b, (float*)(ws + OFF_PART), (unsigned*)(ws + OFF_BAR) + 64, dry, pass};
    gemm_phase<256, 256, 2, 4, 2, false>(mixb, MT, (const bf16_t*)(ws + OFF_W_OUT0), 1024, 1024, smem, e);
  }
  if constexpr (PH == 5) {
    EpiSwiGLU e{(bf16_t*)(ws + OFF_HID)};
    constexpr int NT = 64 * 22, NFULL = (NT / 256) * 256;
    gemm_phase<256, 256, 2, 4, 2, false>(xb, MT, (const bf16_t*)(ws + OFF_W_GU0), 2 * DFF, 1024, smem, e, 0, NFULL);
    gemm_phase<128, 256, 2, 4, 2, false>(xb, MT, (const bf16_t*)(ws + OFF_W_GU0), 2 * DFF, 1024, smem, e, NFULL, NT);
  }
  if constexpr (PH == 6) {
    EpiLN<false> e{p.out, (bf16_t*)(ws + OFF_XB), p.ffn_g, p.ffn_b, (float*)(ws + OFF_PART) + 131072, (unsigned*)(ws + OFF_BAR) + 128, dry, pass};
    gemm_phase<256, 256, 2, 4, 2, false>((const bf16_t*)(ws + OFF_HID), MT, (const bf16_t*)(ws + OFF_W_DN0), 1024, DFF, smem, e);
  }
  if constexpr (PH == 7) {
    EpiQKV e{(bf16_t*)(ws + OFF_Q), (bf16_t*)(ws + OFF_K), (bf16_t*)(ws + OFF_VT), (const float2*)(ws + OFF_ROPE), 0.125f * 1.4426950408889634f};
    gemm_phase<256, 256, 2, 4, 2, false>(xb, MT, (const bf16_t*)(ws + OFF_W_QKV), 3072, 1024, smem, e);
  }
  if constexpr (PH == 8) { if (ATTN_VAR != 0 && pass == 1) phase_attn<ATTN_VAR>(p, smem); else phase_attn<0>(p, smem); }
  if constexpr (PH == 9) {
    EpiLN<false> e{p.out, (bf16_t*)(ws + OFF_XB), p.mix_g + 1024, p.mix_b + 1024, (float*)(ws + OFF_PART) + 2 * 131072, (unsigned*)(ws + OFF_BAR) + 192, dry, pass};
    gemm_phase<256, 256, 2, 4, 2, false>(mixb, MT, (const bf16_t*)(ws + OFF_W_OUT1), 1024, 1024, smem, e);
  }
  if constexpr (PH == 10) {
    EpiSwiGLU e{(bf16_t*)(ws + OFF_HID)};
    constexpr int NT = 64 * 22, NFULL = (NT / 256) * 256;
    gemm_phase<256, 256, 2, 4, 2, false>(xb, MT, (const bf16_t*)(ws + OFF_W_GU1), 2 * DFF, 1024, smem, e, 0, NFULL);
    gemm_phase<128, 256, 2, 4, 2, false>(xb, MT, (const bf16_t*)(ws + OFF_W_GU1), 2 * DFF, 1024, smem, e, NFULL, NT);
  }
  if constexpr (PH == 11) {
    EpiLN<true> e{p.out, (bf16_t*)(ws + OFF_XB), p.ffn_g + 1024, p.ffn_b + 1024, (float*)(ws + OFF_PART) + 3 * 131072, (unsigned*)(ws + OFF_BAR) + 256, dry, pass};
    gemm_phase<256, 256, 2, 4, 2, false>((const bf16_t*)(ws + OFF_HID), MT, (const bf16_t*)(ws + OFF_W_DN1), 1024, DFF, smem, e);
  }
}
#ifndef BAR_NG
#define BAR_NG 64u
#endif
DI void grid_barrier(unsigned* bar, unsigned gen) {
  __syncthreads();
  if (threadIdx.x == 0) {
    const unsigned g = blockIdx.x & (BAR_NG - 1), gsz = gridDim.x / BAR_NG;
    __builtin_amdgcn_fence(__ATOMIC_RELEASE, "agent");
    const unsigned old = __hip_atomic_fetch_add(bar + 2048 + 64 * g, 1u, __ATOMIC_RELAXED, __HIP_MEMORY_SCOPE_AGENT);
    if (old + 1u == gen * gsz) {
      const unsigned old2 = __hip_atomic_fetch_add(bar, 1u, __ATOMIC_RELAXED, __HIP_MEMORY_SCOPE_AGENT);
      if (old2 + 1u == gen * BAR_NG) {
#pragma unroll
        for (int j = 0; j < BAR_NG; ++j) __hip_atomic_store(bar + 6144 + 64 * j, gen, __ATOMIC_RELAXED, __HIP_MEMORY_SCOPE_AGENT);
      }
    }
    while (__hip_atomic_load(bar + 6144 + 64 * g, __ATOMIC_RELAXED, __HIP_MEMORY_SCOPE_AGENT) < gen) __builtin_amdgcn_s_sleep(1);
    __builtin_amdgcn_fence(__ATOMIC_ACQUIRE, "agent");
  }
  __syncthreads();
}
DI void group_barrier(unsigned* ctr, unsigned target) {
  __syncthreads();
  if (threadIdx.x == 0) {
    __builtin_amdgcn_fence(__ATOMIC_RELEASE, "agent");
    __hip_atomic_fetch_add(ctr, 1u, __ATOMIC_RELAXED, __HIP_MEMORY_SCOPE_AGENT);
    while (__hip_atomic_load(ctr, __ATOMIC_RELAXED, __HIP_MEMORY_SCOPE_AGENT) < target) __builtin_amdgcn_s_sleep(1);
    __builtin_amdgcn_fence(__ATOMIC_ACQUIRE, "agent");
  }
  __syncthreads();
}
#ifndef EXTRA_BAR
#define EXTRA_BAR 0
#endif
#ifndef DUP_BAR
#define DUP_BAR 0
#endif
template <int PH, int P1>
DI void run_from(const Params& p, char* smem, unsigned& gen) {
  if constexpr (PH == 0) {
    if (blockIdx.x == 0) { for (int i = threadIdx.x; i < 32768; i += NTHR) __hip_atomic_store((unsigned*)(p.ws + OFF_BAR) + i, 0u, __ATOMIC_RELAXED, __HIP_MEMORY_SCOPE_AGENT); }
  }
  if constexpr ((DUP_MASK >> PH) & 1) { run_phase<PH>(p, smem, 1, 0); if (DUP_BAR) grid_barrier((unsigned*)(p.ws + OFF_BAR) + 4096, ++gen); run_phase<PH>(p, smem, 0, 1); }
  else run_phase<PH>(p, smem);
  if constexpr (PH + 1 < P1) {
    if constexpr (PH == 0) cg::this_grid().sync();
    else if constexpr (PH == 4 || PH == 5 || PH == 9 || PH == 10) {
      if (gridDim.x == 256) {
        constexpr unsigned k = (PH == 4) ? 1u : (PH == 5) ? 2u : (PH == 9) ? 3u : 4u;
        const unsigned grp = (blockIdx.x & 7u) * 8u + ((blockIdx.x >> 3) & 7u);
        group_barrier((unsigned*)(p.ws + OFF_BAR) + 16384 + 64 * grp, 4u * k);
      } else {
        grid_barrier((unsigned*)(p.ws + OFF_BAR) + 4096, ++gen);
      }
    }
    else if constexpr (PH == 1 || PH == 3 || PH == 7) {
      if (gridDim.x == 256) group_barrier((unsigned*)(p.ws + OFF_BAR) + 24576 + 64 * (blockIdx.x & 7u), (PH == 1) ? 32u : (PH == 3) ? 64u : 96u);
      else grid_barrier((unsigned*)(p.ws + OFF_BAR) + 4096, ++gen);
    }
    else if constexpr (PH != 2) grid_barrier((unsigned*)(p.ws + OFF_BAR) + 4096, ++gen);
    if constexpr (PH == 3) { for (int i = 0; i < EXTRA_BAR; ++i) grid_barrier((unsigned*)(p.ws + OFF_BAR) + 4096, ++gen); }
    run_from<PH + 1, P1>(p, smem, gen);
  }
}
template <int P0, int P1>
__global__ void __launch_bounds__(NTHR) fwd_kernel(Params p) {
  __shared__ __attribute__((aligned(16))) char smem[163840];
  unsigned gen = 0;
  run_from<P0, P1>(p, smem, gen);
}

typedef void (*kern_t)(Params);

extern "C" void kernel_launch(void* const* d_in, const int* in_sizes, int n_in, void* d_out, int out_size, void* d_ws, size_t ws_size, hipStream_t stream) {
  static int grid_blocks = 0;
  if (!grid_blocks) {
    int dev = 0, cus = 0, per_cu = 0;
    (void)hipGetDevice(&dev);
    (void)hipDeviceGetAttribute(&cus, hipDeviceAttributeMultiprocessorCount, dev);
#if MK_SINGLE
    (void)hipOccupancyMaxActiveBlocksPerMultiprocessor(&per_cu, fwd_kernel<0, 12>, NTHR, 0);
#else
    per_cu = 1;
#endif
    if (per_cu < 1) per_cu = 1;
    if (cus < 1) cus = 256;
    grid_blocks = (cus * per_cu) & ~63;
  }
  Params p{};
  const float** f = (const float**)&p;
  for (int i = 0; i < 29; ++i) f[i] = (const float*)d_in[i];
  p.out = (float*)d_out; p.ws = (char*)d_ws;
#if MK_SINGLE
  void* args[] = {&p};
  hipError_t e = hipLaunchCooperativeKernel((void*)fwd_kernel<0, 12>, dim3(grid_blocks), dim3(NTHR), args, 0, stream);
  if (e != hipSuccess) fprintf(stderr, "cooperative launch failed: %s (grid %d)\n", hipGetErrorString(e), grid_blocks);
#else
  static const kern_t ks[12] = {fwd_kernel<0, 1>, fwd_kernel<1, 2>, fwd_kernel<2, 3>, fwd_kernel<3, 4>, fwd_kernel<4, 5>, fwd_kernel<5, 6>,
                                fwd_kernel<6, 7>, fwd_kernel<7, 8>, fwd_kernel<8, 9>, fwd_kernel<9, 10>, fwd_kernel<10, 11>, fwd_kernel<11, 12>};
  for (int ph = 0; ph < 12; ++ph) hipLaunchKernelGGL(ks[ph], dim3(grid_blocks), dim3(NTHR), 0, stream, p);
#endif
}
```
